# Optimizing an MI355X kernel written in HIP

```python
import jax, jax.numpy as jnp
from jax import lax
import numpy as np

D_MODEL = 1024
BATCH = 4
SEQ = 4096
DEPTH = 4

N_HEADS = 16
HEAD_DIM = 64
N_KV_HEADS = 4
ROT_DIM = HEAD_DIM // 4
ROPE_THETA = 500000.0
MOBA_BLOCK = 256
MOBA_TOPK = 3
MOBA_QCHUNK = 32
WINDOW = 128
D_FF = 2816
CONV_W = 3
N_A = DEPTH // 2
N_B = DEPTH - N_A
EPS = 1e-6
NEG = -1e30

kernel_name = 'yoco_moba_swa_sink_convffn'


def rmsnorm(x, g):
    xf = x.astype(jnp.float32)
    y = xf * lax.rsqrt(jnp.mean(xf * xf, axis=-1, keepdims=True) + EPS)
    return (y * g.astype(jnp.float32)).astype(x.dtype)


def rope_tables(positions):
    inv_freq = ROPE_THETA ** (-jnp.arange(0, ROT_DIM, 2, dtype=jnp.float32) / ROT_DIM)
    ang = positions.astype(jnp.float32)[..., None] * inv_freq
    return jnp.cos(ang)[:, :, None, :], jnp.sin(ang)[:, :, None, :]


def partial_rope(x, cos, sin):
    half = ROT_DIM // 2
    x1 = x[..., :half].astype(jnp.float32)
    x2 = x[..., half:ROT_DIM].astype(jnp.float32)
    r1 = (x1 * cos - x2 * sin).astype(x.dtype)
    r2 = (x2 * cos + x1 * sin).astype(x.dtype)
    return jnp.concatenate([r1, r2, x[..., ROT_DIM:]], axis=-1)


def moba_attention(q, k, v):
    B_, H_, S_, dh = q.shape
    nb = -(-S_ // MOBA_BLOCK)
    pad = nb * MOBA_BLOCK - S_
    kp = jnp.pad(k, ((0, 0), (0, 0), (0, pad), (0, 0)))
    vp = jnp.pad(v, ((0, 0), (0, 0), (0, pad), (0, 0)))
    kb = kp.reshape(B_, H_, nb, MOBA_BLOCK, dh)
    vb = vp.reshape(B_, H_, nb, MOBA_BLOCK, dh)
    k_mean = jnp.mean(kb.astype(jnp.float32), axis=3)
    q_blk = jnp.arange(S_) // MOBA_BLOCK
    gate = jnp.einsum('bhsd,bhnd->bhsn', q.astype(jnp.float32), k_mean)
    past = jnp.arange(nb)[None, :] < q_blk[:, None]
    gate = jnp.where(past, gate, NEG)
    n_sel = min(MOBA_TOPK, nb)
    _, sel_idx = lax.top_k(gate, n_sel)
    sel_valid = jnp.arange(n_sel)[None, :] < q_blk[:, None]
    scale = HEAD_DIM ** -0.5
    bi = jnp.arange(B_)[:, None, None, None]
    hi = jnp.arange(H_)[None, :, None, None]
    qpos_local = jnp.arange(MOBA_QCHUNK)
    kpos_local = jnp.arange(MOBA_BLOCK)

    def chunk(c):
        q0 = c * MOBA_QCHUNK
        qc = lax.dynamic_slice_in_dim(q, q0, MOBA_QCHUNK, axis=2)
        idx = lax.dynamic_slice_in_dim(sel_idx, q0, MOBA_QCHUNK, axis=2)
        valid = lax.dynamic_slice_in_dim(sel_valid, q0, MOBA_QCHUNK, axis=0)
        k_g = kb[bi, hi, idx]
        v_g = vb[bi, hi, idx]
        l_sel = jnp.einsum('bhqd,bhqnpd->bhqnp', qc, k_g).astype(jnp.float32) * scale
        l_sel = jnp.where(valid[None, None, :, :, None], l_sel, NEG)
        l_sel = l_sel.reshape(B_, H_, MOBA_QCHUNK, n_sel * MOBA_BLOCK)
        own0 = (q0 // MOBA_BLOCK) * MOBA_BLOCK
        k_own = lax.dynamic_slice_in_dim(kp, own0, MOBA_BLOCK, axis=2)
        v_own = lax.dynamic_slice_in_dim(vp, own0, MOBA_BLOCK, axis=2)
        l_own = jnp.einsum('bhqd,bhpd->bhqp', qc, k_own).astype(jnp.float32) * scale
        causal = (own0 + kpos_local)[None, :] <= (q0 + qpos_local)[:, None]
        l_own = jnp.where(causal, l_own, NEG)
        p = jax.nn.softmax(jnp.concatenate([l_sel, l_own], axis=-1), axis=-1).astype(v.dtype)
        p_sel = p[..., :n_sel * MOBA_BLOCK].reshape(B_, H_, MOBA_QCHUNK, n_sel, MOBA_BLOCK)
        p_own = p[..., n_sel * MOBA_BLOCK:]
        return (jnp.einsum('bhqnp,bhqnpd->bhqd', p_sel, v_g)
                + jnp.einsum('bhqp,bhpd->bhqd', p_own, v_own))

    out = lax.map(chunk, jnp.arange(S_ // MOBA_QCHUNK))
    return out.transpose(1, 2, 0, 3, 4).reshape(B_, H_, S_, dh)


def swa_sink_attention(q, k, v, sinks):
    B_, Hq, S_, dh = q.shape
    G = Hq // N_KV_HEADS
    nq = S_ // WINDOW
    qb = q.reshape(B_, N_KV_HEADS, G, nq, WINDOW, dh)
    kb = k.reshape(B_, N_KV_HEADS, nq, WINDOW, dh)
    vb = v.reshape(B_, N_KV_HEADS, nq, WINDOW, dh)
    kcat = jnp.concatenate([jnp.pad(kb, ((0, 0), (0, 0), (1, 0), (0, 0), (0, 0)))[:, :, :-1], kb], axis=3)
    vcat = jnp.concatenate([jnp.pad(vb, ((0, 0), (0, 0), (1, 0), (0, 0), (0, 0)))[:, :, :-1], vb], axis=3)
    logits = jnp.einsum('bkgnqd,bknpd->bkgnqp', qb, kcat).astype(jnp.float32) * (HEAD_DIM ** -0.5)
    rel = (jnp.arange(WINDOW)[:, None] + WINDOW) - jnp.arange(2 * WINDOW)[None, :]
    band = (rel >= 0) & (rel < WINDOW)
    key_pos = jnp.arange(nq)[:, None, None] * WINDOW - WINDOW + jnp.arange(2 * WINDOW)[None, None, :]
    mask = band[None] & (key_pos >= 0)
    logits = jnp.where(mask, logits, NEG)
    sink = sinks.astype(jnp.float32).reshape(N_KV_HEADS, G)[None, :, :, None, None, None]
    m = jnp.maximum(jnp.max(logits, axis=-1, keepdims=True), sink)
    e = jnp.exp(logits - m)
    p = e / (jnp.sum(e, axis=-1, keepdims=True) + jnp.exp(sink - m))
    out = jnp.einsum('bkgnqp,bknpd->bkgnqd', p.astype(v.dtype), vcat)
    return out.reshape(B_, Hq, S_, dh)


def conv_ffn(h, w_up, conv_w, conv_b, w_down):
    S_ = h.shape[1]
    u = h @ w_up
    up = jnp.pad(u, ((0, 0), (CONV_W - 1, 0), (0, 0)))
    u = conv_b + sum(conv_w[j] * up[:, j:j + S_] for j in range(CONV_W))
    gate, val = jnp.split(u, 2, axis=-1)
    return (jax.nn.silu(gate) * val) @ w_down


def setup_inputs(seed: int = 0) -> dict:
    key = jax.random.key(seed)
    ks = jax.random.split(key, 20)
    D = D_MODEL
    kv_w = 2 * N_KV_HEADS * HEAD_DIM
    res_scale = (2 * DEPTH) ** -0.5

    def nrm(k, shape, fan_in, extra=1.0):
        return jax.random.normal(k, shape, jnp.float32) * (fan_in ** -0.5) * extra

    def gain(k, shape):
        return 1.0 + 0.02 * jax.random.normal(k, shape, jnp.float32)

    offset = jax.random.randint(ks[1], (BATCH, 1), 0, 1024, dtype=jnp.int32)
    positions = offset + jnp.arange(SEQ, dtype=jnp.int32)[None, :]
    return {
        'x': jax.random.normal(ks[0], (BATCH, SEQ, D), jnp.float32),
        'positions': positions,
        'attn_norm': gain(ks[2], (DEPTH, D)),
        'w_qkv_a': nrm(ks[3], (N_A, D, 3 * N_HEADS * HEAD_DIM), D),
        'w_o_a': nrm(ks[4], (N_A, N_HEADS * HEAD_DIM, D), N_HEADS * HEAD_DIM, res_scale),
        'kv_norm': gain(ks[5], (D,)),
        'w_kv_b': nrm(ks[6], (D, kv_w), D),
        'w_q_b': nrm(ks[7], (N_B, D, N_HEADS * HEAD_DIM), D),
        'sinks_b': 0.5 * jax.random.normal(ks[8], (N_B, N_HEADS), jnp.float32),
        'w_o_b': nrm(ks[9], (N_B, N_HEADS * HEAD_DIM, D), N_HEADS * HEAD_DIM, res_scale),
        'ffn_norm': gain(ks[10], (DEPTH, D)),
        'w_up': nrm(ks[11], (DEPTH, D, 2 * D_FF), D),
        'conv_w': nrm(ks[12], (DEPTH, CONV_W, 2 * D_FF), CONV_W),
        'conv_b': 0.01 * jax.random.normal(ks[13], (DEPTH, 2 * D_FF), jnp.float32),
        'w_down': nrm(ks[14], (DEPTH, D_FF, D), D_FF, res_scale),
        'final_norm': gain(ks[15], (D,)),
    }


def reference(x, positions, attn_norm, w_qkv_a, w_o_a, kv_norm, w_kv_b, w_q_b, sinks_b,
              w_o_b, ffn_norm, w_up, conv_w, conv_b, w_down, final_norm):
    B_, S_, _ = x.shape
    cos, sin = rope_tables(positions)

    def heads(t, n):
        return t.reshape(B_, S_, n, HEAD_DIM)

    def to_bhsd(t):
        return t.transpose(0, 2, 1, 3)

    shared_k = None
    shared_v = None
    for l in range(DEPTH):
        if l < N_A:
            h = rmsnorm(x, attn_norm[l])
            q, k, v = jnp.split(h @ w_qkv_a[l], 3, axis=-1)
            q = partial_rope(heads(q, N_HEADS), cos, sin)
            k = partial_rope(heads(k, N_HEADS), cos, sin)
            o = moba_attention(to_bhsd(q), to_bhsd(k), to_bhsd(heads(v, N_HEADS)))
            w_o = w_o_a[l]
        else:
            if l == N_A:
                hk = rmsnorm(x, kv_norm)
                k, v = jnp.split(hk @ w_kv_b, 2, axis=-1)
                shared_k = to_bhsd(partial_rope(heads(k, N_KV_HEADS), cos, sin))
                shared_v = to_bhsd(heads(v, N_KV_HEADS))
            i = l - N_A
            h = rmsnorm(x, attn_norm[l])
            q = partial_rope(heads(h @ w_q_b[i], N_HEADS), cos, sin)
            o = swa_sink_attention(to_bhsd(q), shared_k, shared_v, sinks_b[i])
            w_o = w_o_b[i]
        x = x + o.transpose(0, 2, 1, 3).reshape(B_, S_, N_HEADS * HEAD_DIM) @ w_o
        x = x + conv_ffn(rmsnorm(x, ffn_norm[l]), w_up[l], conv_w[l], conv_b[l], w_down[l])
    return rmsnorm(x, final_norm)
```

```cpp
#include <hip/hip_runtime.h>
#include <hip/hip_cooperative_groups.h>
#include <cstdio>
#include <cstdint>
namespace cg = cooperative_groups;
__device__ __forceinline__ int pg8_lane_now() { int l; asm volatile("v_mbcnt_lo_u32_b32 %0, -1, 0\n\tv_mbcnt_hi_u32_b32 %0, -1, %0" : "=v"(l)); return l; }
namespace pg8 {
#define PG8_LAS __attribute__((address_space(3)))
typedef unsigned short bf16_t;
typedef short bf16x8 __attribute__((ext_vector_type(8)));
typedef float f32x4 __attribute__((ext_vector_type(4)));
typedef unsigned u32x4 __attribute__((ext_vector_type(4)));
constexpr int BM = 256, BK = 64, HALF = 128, HTB = HALF * BK * 2  , STAGE_BYTES = 8 * HTB, NXCD = 8, WGM = 8;

__host__ __device__ __forceinline__ int lds_byte(int r, int c) { const int st = (r >> 4) * 2 + (c >> 5), rr = r & 15, cc = c & 31, ob = rr * 64 + cc * 2; return st * 1024 + (ob ^ (((ob >> 9) & 1) << 5)); }
__host__ __device__ __forceinline__ void stage_rc(int b, int& R, int& C) { const int st = b / 1024, sb = b % 1024, swz = sb ^ (((sb >> 9) & 1) << 5); R = (st >> 1) * 16 + swz / 64; C = (st & 1) * 32 + (swz % 64) / 2; }
__host__ __device__ __forceinline__ int perm32(int rho) { const int n = rho >> 4, i = rho & 15; return 8 * (i >> 2) + 4 * n + (i & 3); }

struct Unit { int pm, pn; };
struct Gemm { const bf16_t* A; const bf16_t* Bt; int M, N, K, lda; };

struct StaticOrder {
    int nM, nN, nwg, G, c;
    __host__ __device__ void init(int M, int N, int G_, int c_) { nM = M / BM; nN = N / BM; nwg = nM * nN; G = G_; c = c_; }
    __host__ __device__ bool next(int i, Unit& u) const {
        const long L = (long)i * G + c; if (L >= nwg) return false;
        int wgid = (int)L; { const int q = nwg / NXCD, r = nwg % NXCD, xcd = wgid % NXCD, off = wgid / NXCD; wgid = (xcd < r ? xcd * (q + 1) : r * (q + 1) + (xcd - r) * q) + off; }
        const int nig = WGM * nN, gid = wgid / nig, fm = gid * WGM, gsz = (nM - fm) < WGM ? (nM - fm) : WGM;
        u.pm = fm + ((wgid % nig) % gsz); u.pn = (wgid % nig) / gsz; return true;
    }
    __device__ __forceinline__ void a_ready(const Unit&) const {}
    __device__ __forceinline__ void done(const Unit&) const {}
};

typedef float f32x2 __attribute__((ext_vector_type(2)));
typedef __bf16 bf16x2_t __attribute__((ext_vector_type(2)));
typedef unsigned u32x2 __attribute__((ext_vector_type(2)));
__device__ __forceinline__ unsigned cvt_pk_bf16(float lo, float hi) { f32x2 v = {lo, hi}; bf16x2_t b = __builtin_convertvector(v, bf16x2_t); return __builtin_bit_cast(unsigned, b); }
constexpr float RMS_EPS = 1e-6f;
__device__ __forceinline__ void row_rstd(const float* ssq, int row0, int fq, float (&rs)[2][4]) {
#pragma unroll
    for (int ai = 0; ai < 2; ++ai)
#pragma unroll
        for (int m = 0; m < 4; ++m) { const f32x4 p = *(const f32x4*)(ssq + (size_t)(row0 + ai * HALF + m * 16) * 16 + fq * 4);
            float s = (p[0] + p[1]) + (p[2] + p[3]); s += __shfl_xor(s, 16); s += __shfl_xor(s, 32); rs[ai][m] = 1.0f / sqrtf(s * (1.0f / 1024.0f) + RMS_EPS); }
}
struct EpiQKV {
    static constexpr bool PERM = true, AFTER_DRAIN = false;
    bf16_t* Q; bf16_t* Kd; bf16_t* Vt; const float* ssq; const float* cs; float* kmp; int nQ, nK, kpitch; float qscale;
    __device__ __forceinline__ void operator()(const f32x4 (&acc)[2][2][4][2], const Unit& u, int wr, int wc, int fr, int fq) const {
        const int row0 = u.pm * BM + wr * 64 + fr;
        float rs[2][4]; row_rstd(ssq, row0, fq, rs);
        const int type = u.pn < nQ ? 0 : (u.pn < nQ + nK ? 1 : 2);
        const bool rope = (type != 2) && ((wc & 1) == 0);
        const float sgn = (fq == 0) ? -1.f : 1.f; const bool rl = fq < 2;
        const int colw = wc * 32 + 8 * fq;
        f32x4 ks[2][2];
#pragma unroll
        for (int bj = 0; bj < 2; ++bj) { ks[bj][0] = (f32x4){0.f, 0.f, 0.f, 0.f}; ks[bj][1] = (f32x4){0.f, 0.f, 0.f, 0.f}; }
#pragma unroll
        for (int ai = 0; ai < 2; ++ai)
#pragma unroll
            for (int m = 0; m < 4; ++m) {
                const int row = row0 + ai * HALF + m * 16;
                f32x4 c0, c1, s0, s1;
                if (rope) { const f32x4* cp = (const f32x4*)(cs + (size_t)row * 16); c0 = cp[0]; c1 = cp[1]; s0 = cp[2]; s1 = cp[3]; }
                const float r_ = rs[ai][m] * (type == 0 ? qscale : 1.f);
#pragma unroll
                for (int bj = 0; bj < 2; ++bj) {
                    f32x4 v0 = acc[ai][bj][m][0], v1 = acc[ai][bj][m][1];
                    if (rope) {
                        f32x4 o0, o1;
#pragma unroll
                        for (int j = 0; j < 4; ++j) { o0[j] = __shfl_xor(v0[j], 16); o1[j] = __shfl_xor(v1[j], 16); }
                        if (rl) { v0 = v0 * c0 + (o0 * s0) * sgn; v1 = v1 * c1 + (o1 * s1) * sgn; }
                    }
                    v0 = v0 * r_; v1 = v1 * r_;
                    if (type == 2) {
                        const int b = row >> 12, s = row & 4095;
                        const int col = (u.pn - nQ - nK) * BM + bj * HALF + colw;
                        bf16_t* vp = Vt + ((size_t)(b * kpitch + col) * 4096 + s);
                        const unsigned w0 = cvt_pk_bf16(v0[0], v0[1]), w1 = cvt_pk_bf16(v0[2], v0[3]), w2 = cvt_pk_bf16(v1[0], v1[1]), w3 = cvt_pk_bf16(v1[2], v1[3]);
                        vp[0 * 4096] = (bf16_t)(w0 & 0xffffu); vp[1 * 4096] = (bf16_t)(w0 >> 16); vp[2 * 4096] = (bf16_t)(w1 & 0xffffu); vp[3 * 4096] = (bf16_t)(w1 >> 16);
                        vp[4 * 4096] = (bf16_t)(w2 & 0xffffu); vp[5 * 4096] = (bf16_t)(w2 >> 16); vp[6 * 4096] = (bf16_t)(w3 & 0xffffu); vp[7 * 4096] = (bf16_t)(w3 >> 16);
                    } else {
                        u32x4 w; w.x = cvt_pk_bf16(v0[0], v0[1]); w.y = cvt_pk_bf16(v0[2], v0[3]); w.z = cvt_pk_bf16(v1[0], v1[1]); w.w = cvt_pk_bf16(v1[2], v1[3]);
                        if (type == 0) *(u32x4*)(Q + (size_t)row * 1024 + u.pn * BM + bj * HALF + colw) = w;
                        else { *(u32x4*)(Kd + (size_t)row * kpitch + (u.pn - nQ) * BM + bj * HALF + colw) = w; ks[bj][0] += v0; ks[bj][1] += v1; }
                    }
                }
            }
        if (type == 1 && kmp) {
#pragma unroll
            for (int bj = 0; bj < 2; ++bj)
#pragma unroll
                for (int n = 0; n < 2; ++n) {
                    f32x4 v = ks[bj][n];
#pragma unroll
                    for (int j = 0; j < 4; ++j) { float t = v[j]; t += __shfl_xor(t, 1); t += __shfl_xor(t, 2); t += __shfl_xor(t, 4); t += __shfl_xor(t, 8); v[j] = t; }
                    if (fr == 0) *(f32x4*)(kmp + ((size_t)(u.pm * 2 + wr) * 1024) + (u.pn - nQ) * BM + bj * HALF + colw + 4 * n) = v;
                }
        }
    }
};
__device__ __forceinline__ float conv_ror1(float x) { float r; asm volatile("v_mov_b32_dpp %0, %1 row_ror:1 row_mask:0xf bank_mask:0xf" : "=v"(r) : "v"(x)); return r; }
__device__ __forceinline__ float conv_ror2(float x) { float r; asm volatile("v_mov_b32_dpp %0, %1 row_ror:2 row_mask:0xf bank_mask:0xf" : "=v"(r) : "v"(x)); return r; }
#define CONV_ROR(x_, n_) ((n_) == 1 ? conv_ror1(x_) : conv_ror2(x_))
struct EpiUpConv {
    static constexpr bool PERM = true, AFTER_DRAIN = false;
    bf16_t* ACT; bf16_t* head; bf16_t* tail; const float* ssq; const float* cw; const float* cb;
    __device__ __forceinline__ void operator()(const f32x4 (&acc)[2][2][4][2], const Unit& u, int wr, int wc, int fr, int fq) const {
        asm volatile("" : "+v"(fr), "+v"(fq));
        const int row0 = u.pm * BM + wr * 64 + fr;
        float rs[2][4]; row_rstd(ssq, row0, fq, rs);
        const int src1 = (fq << 4) | ((fr - 1) & 15), src2 = (fq << 4) | ((fr - 2) & 15);
        const int ch0 = u.pn * HALF + wc * 32 + 8 * fq;
#pragma unroll
        for (int n = 0; n < 2; ++n) {
            asm volatile("" ::: "memory");
            const int ch = ch0 + 4 * n;
            const f32x4 wg0 = *(const f32x4*)(cw + ch), wg1 = *(const f32x4*)(cw + 5632 + ch), wg2 = *(const f32x4*)(cw + 2 * 5632 + ch), bgv = *(const f32x4*)(cb + ch);
            const f32x4 wv0 = *(const f32x4*)(cw + 2816 + ch), wv1 = *(const f32x4*)(cw + 5632 + 2816 + ch), wv2 = *(const f32x4*)(cw + 2 * 5632 + 2816 + ch), bvv = *(const f32x4*)(cb + 2816 + ch);
#pragma unroll
            for (int ai = 0; ai < 2; ++ai) {
                f32x4 g1p = (f32x4){0.f, 0.f, 0.f, 0.f}, g2p = g1p, v1p = g1p, v2p = g1p;
#pragma unroll
                for (int m = 0; m < 4; ++m) {
                    const int row = row0 + ai * HALF + m * 16;
                    f32x4 ug = acc[ai][0][m][n] * rs[ai][m], uv = acc[ai][1][m][n] * rs[ai][m];
                    asm volatile("s_nop 1" : "+v"(ug), "+v"(uv));
                    f32x4 g1, g2, v1, v2;
#pragma unroll
                    for (int j = 0; j < 4; ++j) { g1[j] = CONV_ROR(ug[j], 1); g2[j] = CONV_ROR(ug[j], 2); v1[j] = CONV_ROR(uv[j], 1); v2[j] = CONV_ROR(uv[j], 2); }
                    const f32x4 gp1 = fr >= 1 ? g1 : g1p, gp2 = fr >= 2 ? g2 : g2p, vp1 = fr >= 1 ? v1 : v1p, vp2 = fr >= 2 ? v2 : v2p;
                    const f32x4 gc = bgv + wg0 * gp2 + wg1 * gp1 + wg2 * ug, vc = bvv + wv0 * vp2 + wv1 * vp1 + wv2 * uv;
                    f32x4 r;
#pragma unroll
                    for (int j = 0; j < 4; ++j) r[j] = gc[j] * __builtin_amdgcn_rcpf(1.0f + __builtin_amdgcn_exp2f(-gc[j] * 1.4426950408889634f)) * vc[j];
                    const bool boundary = (m == 0) && (fr < 2);
                    if (!boundary) { u32x2 w; w.x = cvt_pk_bf16(r[0], r[1]); w.y = cvt_pk_bf16(r[2], r[3]); *(u32x2*)(ACT + (size_t)row * 2816 + ch) = w; }
                    if (boundary || (m == 3 && fr >= 14)) {
                        u32x2 a, b; a.x = cvt_pk_bf16(ug[0], ug[1]); a.y = cvt_pk_bf16(ug[2], ug[3]); b.x = cvt_pk_bf16(uv[0], uv[1]); b.y = cvt_pk_bf16(uv[2], uv[3]);
                        bf16_t* dst = (boundary ? head : tail) + ((size_t)(row >> 6) * 2 + (boundary ? fr : fr - 14)) * 5632 + ch;
                        *(u32x2*)dst = a; *(u32x2*)(dst + 2816) = b;
                    }
                    g1p = g1; g2p = g2; v1p = v1; v2p = v2;
                }
            }
        }
    }
};
#ifndef RESID_LO
#define RESID_LO 0
#endif
struct EpiResid {
    static constexpr bool PERM = true, AFTER_DRAIN = false;
    const bf16_t* hin; const bf16_t* lin; bf16_t* hout; bf16_t* lout; float* ssq;
    __device__ __forceinline__ void operator()(const f32x4 (&acc)[2][2][4][2], const Unit& u, int wr, int wc, int fr, int fq) const {
        const int row0 = u.pm * BM + wr * 64 + fr; const int col0 = u.pn * BM + wc * 32 + 8 * fq;
        u32x4 hq[3][2], lq[3][2];
#define RES_LOAD(slot_, g_) do { const size_t off_ = (size_t)(row0 + ((g_) >> 2) * HALF + ((g_) & 3) * 16) * 1024 + col0; \
        _Pragma("unroll") for (int q_ = 0; q_ < 2; ++q_) { hq[slot_][q_] = *(const u32x4*)(hin + off_ + q_ * HALF); if (RESID_LO) lq[slot_][q_] = *(const u32x4*)(lin + off_ + q_ * HALF); } } while (0)
#define RES_UNPK(w_, e_) (((e_) & 1) ? __builtin_bit_cast(float, (w_)[(e_) >> 1] & 0xffff0000u) : __builtin_bit_cast(float, (w_)[(e_) >> 1] << 16))
        RES_LOAD(0, 0); RES_LOAD(1, 1);
#pragma unroll
        for (int g = 0; g < 8; ++g) {
            const int ai = g >> 2, m = g & 3;
            if (g + 2 < 8) RES_LOAD((g + 2) % 3, g + 2);
            const int row = row0 + ai * HALF + m * 16; const size_t off = (size_t)row * 1024 + col0; float ss = 0.f;
#pragma unroll
            for (int bj = 0; bj < 2; ++bj) {
                const u32x4 hv = hq[g % 3][bj];
                float xv[8];
#pragma unroll
                for (int e = 0; e < 8; ++e) { float x0 = RES_UNPK(hv, e); if (RESID_LO) { const u32x4 lv = lq[g % 3][bj]; x0 += RES_UNPK(lv, e); } xv[e] = x0 + acc[ai][bj][m][e >> 2][e & 3]; ss += xv[e] * xv[e]; }
                u32x4 w, wl;
#pragma unroll
                for (int e2 = 0; e2 < 4; ++e2) { w[e2] = cvt_pk_bf16(xv[2 * e2], xv[2 * e2 + 1]);
                    wl[e2] = cvt_pk_bf16(xv[2 * e2] - __builtin_bit_cast(float, w[e2] << 16), xv[2 * e2 + 1] - __builtin_bit_cast(float, w[e2] & 0xffff0000u)); }
                *(u32x4*)(hout + off + bj * HALF) = w; if (RESID_LO) *(u32x4*)(lout + off + bj * HALF) = wl;
            }
            ss += __shfl_xor(ss, 16); ss += __shfl_xor(ss, 32);
            if (fq == 0) ssq[(size_t)row * 16 + u.pn * 4 + wc] = ss;
        }
#undef RES_LOAD
#undef RES_UNPK
    }
};

template <class Epi, class Sched, bool ALIGN_EPI = false, bool SP2 = false>
__device__ __forceinline__ void gemm_phase(PG8_LAS unsigned char* lds, const Gemm g, const Sched& S, const Epi& E, const int tid) {
    const int wid = __builtin_amdgcn_readfirstlane(tid >> 6), lane = tid & 63, wr = wid >> 2, wc = wid & 3, fr = lane & 15, fq = lane >> 4;
    const int K = g.K, nt = K / BK, lda = g.lda;
    unsigned voffA[2], voffB[2];
#pragma unroll
    for (int i = 0; i < 2; ++i) { int R, C; stage_rc(tid * 16 + i * 8192, R, C); const int Rb = Epi::PERM ? ((R & ~31) + perm32(R & 31)) : R;
        voffA[i] = (unsigned)(R * lda + C) * 2u; voffB[i] = (unsigned)(Rb * K + C) * 2u; }
    const size_t kstep = (size_t)(BK * 2);
    const size_t hstep = (size_t)HALF * K * 2;
    const size_t tstep = 2 * hstep; const size_t hstepA = (size_t)HALF * lda * 2, tstepA = 2 * hstepA;
    const unsigned ldsw = (unsigned)wid * 1024u;
    const int aoff = lds_byte(wr * 64 + fr, fq * 8), boff = lds_byte(wc * 32 + fr, fq * 8);
#define PG8_SA(b, h) (((b) * 2 + (h)) * HTB)
#define PG8_SB(b, h) ((4 + (b) * 2 + (h)) * HTB)
#define PG8_STAGE(bufoff, gbase, voff) do { _Pragma("unroll") for (int _i = 0; _i < 2; ++_i) \
        __builtin_amdgcn_global_load_lds((const unsigned*)((const char*)(gbase) + (voff)[_i]), (PG8_LAS unsigned*)(lds + (bufoff) + ldsw + _i * 8192), 16, 0, 0); } while (0)
#define PG8_LDA(dst, b, h) do { _Pragma("unroll") for (int m = 0; m < 4; ++m) _Pragma("unroll") for (int k = 0; k < 2; ++k) dst[m][k] = *(const PG8_LAS bf16x8*)(lds + PG8_SA(b, h) + aoff + m * 2048 + k * 1024); } while (0)
#define PG8_LDB(dst, b, h) do { _Pragma("unroll") for (int n = 0; n < 2; ++n) _Pragma("unroll") for (int k = 0; k < 2; ++k) dst[n][k] = *(const PG8_LAS bf16x8*)(lds + PG8_SB(b, h) + boff + n * 2048 + k * 1024); } while (0)
#define PG8_MMA(ai, bj, At, Bt) do { __builtin_amdgcn_s_setprio(1); _Pragma("unroll") for (int m = 0; m < 4; ++m) _Pragma("unroll") for (int n = 0; n < 2; ++n) _Pragma("unroll") for (int k = 0; k < 2; ++k) \
        acc[ai][bj][m][n] = __builtin_amdgcn_mfma_f32_16x16x32_bf16(Bt[n][k], At[m][k], acc[ai][bj][m][n], 0, 0, 0); __builtin_amdgcn_s_setprio(0); } while (0)
#define PG8_WAIT_V(n) asm volatile("s_waitcnt vmcnt(" #n ")" ::: "memory")
#define PG8_WAIT_L(n) asm volatile("s_waitcnt lgkmcnt(" #n ")" ::: "memory")
#define PG8_BAR __builtin_amdgcn_s_barrier()
#define PG8_SCHED __builtin_amdgcn_sched_barrier(0)
    Unit cur, nxt; int ui = 0;
    if (!S.next(0, cur)) return;
    f32x4 acc[2][2][4][2];
#pragma unroll
    for (int a = 0; a < 2; ++a)
#pragma unroll
        for (int b = 0; b < 2; ++b)
#pragma unroll
            for (int m = 0; m < 4; ++m)
#pragma unroll
                for (int n = 0; n < 2; ++n) acc[a][b][m][n] = (f32x4){0.f, 0.f, 0.f, 0.f};
    bf16x8 At[4][2], B0[2][2], B1[2][2];
    const char* cA = (const char*)g.A + (size_t)cur.pm * tstepA; const char* cB = (const char*)g.Bt + (size_t)cur.pn * tstep;
    S.a_ready(cur);
    if constexpr (SP2) {
        PG8_STAGE(PG8_SB(0, 0), cB, voffB); PG8_STAGE(PG8_SB(0, 1), cB + hstep, voffB); PG8_STAGE(PG8_SA(0, 0), cA, voffA); PG8_STAGE(PG8_SA(0, 1), cA + hstepA, voffA);
        if (wr == 1) PG8_BAR;
        PG8_WAIT_V(2); PG8_BAR;
        PG8_STAGE(PG8_SB(1, 0), cB + kstep, voffB); PG8_STAGE(PG8_SA(1, 0), cA + kstep, voffA); PG8_STAGE(PG8_SB(1, 1), cB + hstep + kstep, voffB);
        PG8_WAIT_V(6); PG8_BAR;
    } else {
        PG8_STAGE(PG8_SB(0, 0), cB, voffB); PG8_STAGE(PG8_SA(0, 0), cA, voffA); PG8_STAGE(PG8_SB(0, 1), cB + hstep, voffB); PG8_STAGE(PG8_SA(0, 1), cA + hstepA, voffA);
        if (wr == 1) PG8_BAR;
        PG8_WAIT_V(4); PG8_BAR;
        PG8_STAGE(PG8_SB(1, 0), cB + kstep, voffB); PG8_STAGE(PG8_SA(1, 0), cA + kstep, voffA); PG8_STAGE(PG8_SB(1, 1), cB + hstep + kstep, voffB);
        PG8_WAIT_V(6); PG8_BAR;
    }
    for (;;) {
        const bool has_next = S.next(ui + 1, nxt);
        const char* nA = has_next ? (const char*)g.A + (size_t)nxt.pm * tstepA : cA; const char* nB = has_next ? (const char*)g.Bt + (size_t)nxt.pn * tstep : cB;
        for (int t = 0; t < nt; t += 2) {
            const bool last = (t == nt - 2);
            const char* a1 = cA + (size_t)(t + 1) * kstep;
            const char* a2 = last ? nA : cA + (size_t)(t + 2) * kstep; const char* b2 = last ? nB : cB + (size_t)(t + 2) * kstep;
            const char* a3 = a2 + kstep; const char* b3 = b2 + kstep;
            if (last && has_next) S.a_ready(nxt);
            if constexpr (SP2) {
            PG8_LDB(B0, 0, 0); PG8_LDB(B1, 0, 1); PG8_SCHED; PG8_LDA(At, 0, 0); PG8_STAGE(PG8_SA(1, 1), a1 + hstepA, voffA);
            PG8_WAIT_V(8); PG8_WAIT_L(0); PG8_BAR; PG8_MMA(0, 0, At, B0); PG8_MMA(0, 1, At, B1); PG8_BAR; PG8_SCHED;
            PG8_LDA(At, 0, 1); PG8_STAGE(PG8_SB(0, 0), b2, voffB); PG8_STAGE(PG8_SB(0, 1), b2 + hstep, voffB); PG8_STAGE(PG8_SA(0, 0), a2, voffA);
            PG8_WAIT_V(8); PG8_WAIT_L(0); PG8_BAR; PG8_MMA(1, 0, At, B0); PG8_MMA(1, 1, At, B1); PG8_BAR; PG8_SCHED;
            PG8_LDB(B0, 1, 0); PG8_LDB(B1, 1, 1); PG8_SCHED; PG8_LDA(At, 1, 0); PG8_STAGE(PG8_SA(0, 1), a2 + hstepA, voffA);
            PG8_WAIT_V(8); PG8_WAIT_L(0); PG8_BAR; PG8_MMA(0, 0, At, B0); PG8_MMA(0, 1, At, B1); PG8_BAR; PG8_SCHED;
            PG8_LDA(At, 1, 1); PG8_STAGE(PG8_SB(1, 0), b3, voffB); PG8_STAGE(PG8_SB(1, 1), b3 + hstep, voffB); PG8_STAGE(PG8_SA(1, 0), a3, voffA);
            PG8_WAIT_V(8); PG8_WAIT_L(0); PG8_BAR; PG8_MMA(1, 0, At, B0); PG8_MMA(1, 1, At, B1); PG8_BAR; PG8_SCHED;
            } else {
            PG8_LDB(B0, 0, 0); PG8_SCHED; PG8_LDA(At, 0, 0); PG8_STAGE(PG8_SA(1, 1), a1 + hstepA, voffA);
            PG8_WAIT_L(8); PG8_BAR; PG8_WAIT_L(0); PG8_MMA(0, 0, At, B0); PG8_BAR; PG8_SCHED;
            PG8_LDB(B1, 0, 1); PG8_STAGE(PG8_SB(0, 0), b2, voffB);
            PG8_BAR; PG8_WAIT_L(0); PG8_MMA(0, 1, At, B1); PG8_BAR;
            PG8_LDA(At, 0, 1); PG8_STAGE(PG8_SA(0, 0), a2, voffA);
            PG8_BAR; PG8_WAIT_L(0); PG8_MMA(1, 0, At, B0); PG8_BAR; PG8_SCHED;
            PG8_STAGE(PG8_SB(0, 1), b2 + hstep, voffB);
            PG8_WAIT_V(6); PG8_BAR; PG8_MMA(1, 1, At, B1); PG8_BAR;
            PG8_LDB(B0, 1, 0); PG8_SCHED; PG8_LDA(At, 1, 0); PG8_STAGE(PG8_SA(0, 1), a2 + hstepA, voffA);
            PG8_WAIT_L(8); PG8_BAR; PG8_WAIT_L(0); PG8_MMA(0, 0, At, B0); PG8_BAR; PG8_SCHED;
            PG8_LDB(B1, 1, 1); PG8_STAGE(PG8_SB(1, 0), b3, voffB);
            PG8_BAR; PG8_WAIT_L(0); PG8_MMA(0, 1, At, B1); PG8_BAR;
            PG8_LDA(At, 1, 1); PG8_STAGE(PG8_SA(1, 0), a3, voffA);
            PG8_BAR; PG8_WAIT_L(0); PG8_MMA(1, 0, At, B0); PG8_BAR; PG8_SCHED;
            PG8_STAGE(PG8_SB(1, 1), b3 + hstep, voffB);
            PG8_WAIT_V(6); PG8_BAR; PG8_MMA(1, 1, At, B1); PG8_BAR;
            }
        }
        if constexpr (ALIGN_EPI) { if (wr == 0) PG8_BAR; }
        if constexpr (!Epi::AFTER_DRAIN) { const int l2_ = pg8_lane_now(); E(acc, cur, wr, wc, l2_ & 15, l2_ >> 4); S.done(cur); }
        if (!has_next) break;
#pragma unroll
        for (int a = 0; a < 2; ++a)
#pragma unroll
            for (int b = 0; b < 2; ++b)
#pragma unroll
                for (int m = 0; m < 4; ++m)
#pragma unroll
                    for (int n = 0; n < 2; ++n) acc[a][b][m][n] = (f32x4){0.f, 0.f, 0.f, 0.f};
        cur = nxt; cA = nA; cB = nB; ++ui;
        if constexpr (ALIGN_EPI) { if (wr == 1) PG8_BAR; }
    }
    PG8_WAIT_V(0);
    if constexpr (!ALIGN_EPI) { if (wr == 0) PG8_BAR; }
    PG8_BAR;
    if constexpr (Epi::AFTER_DRAIN) { E.fused(acc, cur, wr, wc, fr, fq, lds, wid, lane); S.done(cur); }
#undef PG8_SA
#undef PG8_SB
#undef PG8_STAGE
#undef PG8_LDA
#undef PG8_LDB
#undef PG8_MMA
#undef PG8_WAIT_V
#undef PG8_WAIT_L
#undef PG8_BAR
#undef PG8_SCHED
}
}

#define LAS __attribute__((address_space(3)))
typedef unsigned short bf16;
typedef short bf16x8 __attribute__((ext_vector_type(8)));
typedef short s16x4 __attribute__((ext_vector_type(4)));
typedef float f32x4 __attribute__((ext_vector_type(4)));
typedef float f32x16 __attribute__((ext_vector_type(16)));
typedef unsigned u32x4 __attribute__((ext_vector_type(4)));
typedef unsigned u32x2 __attribute__((ext_vector_type(2)));
constexpr int NWAVES = 8;
constexpr int BATCH = 4, SEQ = 4096, D = 1024, H = 16, HD = 64, NKV = 4, DFF = 2816, DFF2 = 5632, M = BATCH * SEQ;
constexpr float C2 = 0.125f * 1.4426950408889634f;
constexpr size_t MiB = 1u << 20;
constexpr size_t WS_CS = 1 * MiB, WS_SSQ = 2 * MiB, WS_KMP = 3 * MiB;
constexpr size_t WS_WQKV = 4 * MiB;
constexpr size_t WS_WO = 16 * MiB;
constexpr size_t WS_WQ2 = 24 * MiB;
constexpr size_t WS_WQ3 = 27 * MiB;
constexpr size_t WS_WUP = 29 * MiB;
constexpr size_t WS_WDN = 73 * MiB;
constexpr size_t WS_XB = 96 * MiB;
constexpr size_t WS_KS = 128 * MiB;
constexpr size_t WS_VTS = 136 * MiB;
constexpr size_t WS_QO = 144 * MiB, WS_K = 176 * MiB, WS_VT = 208 * MiB;
constexpr size_t WS_O = 240 * MiB;
constexpr size_t WS_U = 144 * MiB;
constexpr size_t WS_HALO = 320 * MiB;
constexpr size_t WS_PO0 = 240 * MiB;
constexpr size_t WS_XH2 = 240 * MiB, WS_XL2 = 272 * MiB;
constexpr size_t WS_PL = 336 * MiB;
constexpr size_t WS_LISTS = 128 * MiB;
constexpr size_t WS_COUNTS = 32768;
constexpr size_t WS_END = 340 * MiB;
constexpr int LDS_BYTES = 163840;

__device__ __forceinline__ float wave_sum(float v) {
#pragma unroll
    for (int o = 1; o < 64; o <<= 1) v += __shfl_xor(v, o);
    return v;
}
__device__ __forceinline__ float bf2f(unsigned short b) { return __builtin_bit_cast(float, (unsigned)b << 16); }
using pg8::cvt_pk_bf16;

__device__ __forceinline__ void transpose_item(const float* W, const float* g, int K, int N, bf16* WT, int rowoff, LAS float* scr, int item, int lane, bool gv_perm = false) {
    const int nblk = N / 32, kb = item / nblk, nb = item % nblk, k0 = 64 * kb, n0 = 32 * nb;
    const int d0 = gv_perm ? ((n0 < DFF) ? (n0 >> 7) * 256 + (n0 & 127) : ((n0 - DFF) >> 7) * 256 + 128 + ((n0 - DFF) & 127)) : rowoff + n0;
#pragma unroll
    for (int i = 0; i < 8; ++i) { const int kk = 8 * i + (lane >> 3), n4 = (lane & 7) * 4; const float gs = g ? g[k0 + kk] : 1.f;
        const f32x4 v = *(const f32x4*)(W + (size_t)(k0 + kk) * N + n0 + n4) * gs; LAS float* d = scr + kk * 33 + n4; d[0] = v[0]; d[1] = v[1]; d[2] = v[2]; d[3] = v[3]; }
    asm volatile("s_waitcnt lgkmcnt(0)" ::: "memory");
    const int c = lane & 7;
#pragma unroll
    for (int j = 0; j < 4; ++j) { const int n = (lane >> 3) + 8 * j; const LAS float* s = scr + (8 * c) * 33 + n;
        u32x4 o; o.x = cvt_pk_bf16(s[0 * 33], s[1 * 33]); o.y = cvt_pk_bf16(s[2 * 33], s[3 * 33]); o.z = cvt_pk_bf16(s[4 * 33], s[5 * 33]); o.w = cvt_pk_bf16(s[6 * 33], s[7 * 33]);
        *(u32x4*)(WT + (size_t)(d0 + n) * K + k0 + 8 * c) = o; }
    asm volatile("s_waitcnt lgkmcnt(0)" ::: "memory");
}

struct Args {
    const float* x; const int* pos; const float* attn_norm; const float* w_qkv_a; const float* w_o_a; const float* kv_norm; const float* w_kv_b; const float* w_q_b;
    const float* sinks_b; const float* w_o_b; const float* ffn_norm; const float* w_up; const float* conv_w; const float* conv_b; const float* w_down; const float* final_norm;
    float* out; unsigned char* ws; int ph_lo, ph_hi;
};

typedef const __attribute__((address_space(4))) Args* ArgsP;
#define a (*ap)
__device__ __forceinline__ void convert_layer(ArgsP ap, LAS unsigned char* lds, int l, int gw, int NGW, int wslot, int lane) {
    gw = __builtin_amdgcn_readfirstlane(gw); NGW = __builtin_amdgcn_readfirstlane(NGW);
    unsigned char* ws = a.ws;
    LAS float* scr = (LAS float*)(lds + wslot * 16384);
    constexpr int I_QKV = 16 * 96, I_SQ = 16 * 32, I_KV = 16 * 16, I_UP = 16 * 176, I_DN = 44 * 32;
    constexpr int B_SQ = 2 * I_QKV, B_KV = B_SQ + 6 * I_SQ, B_UP = B_KV + I_KV, B_DN = B_UP + 4 * I_UP;
    for (int rg = 0; rg < 5; ++rg) {
        int lo_, n_;
        if (rg == 0) { if (l < 2) { lo_ = l * I_QKV; n_ = I_QKV; } else { lo_ = B_SQ + (l + 2) * I_SQ; n_ = I_SQ; } }
        else if (rg == 1) { lo_ = B_SQ + l * I_SQ; n_ = I_SQ; }
        else if (rg == 2) { lo_ = B_UP + l * I_UP; n_ = I_UP; }
        else if (rg == 3) { lo_ = B_DN + l * I_DN; n_ = I_DN; }
        else { lo_ = B_KV; n_ = (l == 2) ? I_KV : 0; }
    for (int it = lo_ + gw; it < lo_ + n_; it += NGW) {
        int r = it;
        if (r < 2 * I_QKV) { const int l2 = r / I_QKV; r -= l2 * I_QKV;
            transpose_item(a.w_qkv_a + (size_t)l2 * D * 3 * D, a.attn_norm + l2 * D, D, 3 * D, (bf16*)(ws + WS_WQKV) + (size_t)l2 * 3 * D * D, 0, scr, r, lane); continue; } r -= 2 * I_QKV;
        if (r < 6 * I_SQ) { const int t = r / I_SQ; r -= t * I_SQ;
            const float* W; const float* g = nullptr; bf16* dst;
            if (t < 2) { W = a.w_o_a + (size_t)t * D * D; dst = (bf16*)(ws + WS_WO) + (size_t)t * D * D; }
            else if (t < 4) { W = a.w_o_b + (size_t)(t - 2) * D * D; dst = (bf16*)(ws + WS_WO) + (size_t)t * D * D; }
            else if (t == 4) { W = a.w_q_b; g = a.attn_norm + 2 * D; dst = (bf16*)(ws + WS_WQ2); }
            else { W = a.w_q_b + (size_t)D * D; g = a.attn_norm + 3 * D; dst = (bf16*)(ws + WS_WQ3); }
            transpose_item(W, g, D, D, dst, 0, scr, r, lane); continue; } r -= 6 * I_SQ;
        if (r < I_KV) { transpose_item(a.w_kv_b, a.kv_norm, D, 512, (bf16*)(ws + WS_WQ2), 1024, scr, r, lane); continue; } r -= I_KV;
        if (r < 4 * I_UP) { const int l2 = r / I_UP; r -= l2 * I_UP;
            transpose_item(a.w_up + (size_t)l2 * D * DFF2, a.ffn_norm + l2 * D, D, DFF2, (bf16*)(ws + WS_WUP) + (size_t)l2 * DFF2 * D, 0, scr, r, lane, true); continue; } r -= 4 * I_UP;
        { const int l2 = r / I_DN; r -= l2 * I_DN;
            transpose_item(a.w_down + (size_t)l2 * DFF * D, nullptr, DFF, D, (bf16*)(ws + WS_WDN) + (size_t)l2 * D * DFF, 0, scr, r, lane); }
    }
    }
}
__device__ __forceinline__ void prologue(ArgsP ap, LAS unsigned char* lds, int gw, int NGW, int lane) {
    gw = __builtin_amdgcn_readfirstlane(gw); NGW = __builtin_amdgcn_readfirstlane(NGW);
    unsigned char* ws = a.ws;
    convert_layer(ap, lds, 0, gw, NGW, gw & 7, lane);
    bf16* xb = (bf16*)(ws + WS_XB); bf16* xl = (bf16*)a.out; float* ssq = (float*)(ws + WS_SSQ);
    for (int m = gw; m < M; m += NGW) {
        const f32x4* xr = (const f32x4*)(a.x + (size_t)m * D) + lane; float s = 0.f;
        unsigned long long* o8 = (unsigned long long*)(xb + (size_t)m * D) + lane; unsigned long long* l8 = (unsigned long long*)(xl + (size_t)m * D) + lane;
#pragma unroll
        for (int j = 0; j < 4; ++j) { const f32x4 v = xr[64 * j]; s += (v[0] * v[0] + v[1] * v[1]) + (v[2] * v[2] + v[3] * v[3]);
            const unsigned h0 = cvt_pk_bf16(v[0], v[1]), h1 = cvt_pk_bf16(v[2], v[3]);
            const unsigned l0 = cvt_pk_bf16(v[0] - bf2f((unsigned short)(h0 & 0xffffu)), v[1] - bf2f((unsigned short)(h0 >> 16))), l1 = cvt_pk_bf16(v[2] - bf2f((unsigned short)(h1 & 0xffffu)), v[3] - bf2f((unsigned short)(h1 >> 16)));
            o8[64 * j] = (unsigned long long)h0 | ((unsigned long long)h1 << 32); if (RESID_LO) l8[64 * j] = (unsigned long long)l0 | ((unsigned long long)l1 << 32); }
        s = wave_sum(s);
        if (lane < 16) ssq[(size_t)m * 16 + lane] = (lane == 0) ? s : 0.f;
    }
    float* cs = (float*)(ws + WS_CS);
    const int gt = gw * 64 + lane, NT = NGW * 64;
    for (int i = gt; i < M * 8; i += NT) {
        const int m = i >> 3, k = i & 7;
        const double c1 = 0.19392274474868576, c2 = c1 * c1, c4 = c2 * c2;
        const double invf = ((k & 1) ? c1 : 1.0) * ((k & 2) ? c2 : 1.0) * ((k & 4) ? c4 : 1.0);
        const double ang = (double)a.pos[m] * invf;
        const double kk = __builtin_rint(ang * 0.15915494309189535);
        const double rr = ang - kk * 6.283185307179586;
        const float rf = (float)rr, r2 = rf * rf;
        float ts = 1.f, tc = 1.f;
#pragma unroll 1
        for (int q = 14; q >= 1; --q) { const float da = (float)((2 * q) * (2 * q + 1)), db = (float)((2 * q - 1) * (2 * q)); ts = 1.f - r2 * ts * __builtin_amdgcn_rcpf(da); tc = 1.f - r2 * tc * __builtin_amdgcn_rcpf(db); }
        cs[(size_t)m * 16 + k] = tc; cs[(size_t)m * 16 + 8 + k] = rf * ts;
    }
}

#ifndef PROBE_TASKREP
#define PROBE_TASKREP 1
#endif
#define PROBE_STOREREP 1
#define PROBE_UNITREP 1
namespace att {
constexpr int KSTR = 144, VSTR = 136;
constexpr int KTILE = 64 * KSTR, VTILE = 64 * VSTR;
__device__ __forceinline__ int crow(int r, int hi) { return (r & 3) + 8 * (r >> 2) + 4 * hi; }
constexpr float MASKED = -3.0e38f, MINIT = -1.0e30f;
enum { MK_NONE = 0, MK_CAUSAL = 1, MK_BAND = 2 };
#define ATT_RD128(dst, base, off) asm volatile("ds_read_b128 %0, %1 offset:%2" : "=v"(dst) : "v"(base), "i"(off))
#define ATT_RD64(dst, base, off) asm volatile("ds_read_b64 %0, %1 offset:%2" : "=v"(dst) : "v"(base), "i"(off))
#define ATT_WAIT8(n, a) asm volatile("s_waitcnt lgkmcnt(" #n ")" : "+v"(a[0]), "+v"(a[1]), "+v"(a[2]), "+v"(a[3]), "+v"(a[4]), "+v"(a[5]), "+v"(a[6]), "+v"(a[7]))
#define ATT_WAIT16(n, a) asm volatile("s_waitcnt lgkmcnt(" #n ")" : "+v"(a[0]), "+v"(a[1]), "+v"(a[2]), "+v"(a[3]), "+v"(a[4]), "+v"(a[5]), "+v"(a[6]), "+v"(a[7]), "+v"(a[8]), "+v"(a[9]), "+v"(a[10]), "+v"(a[11]), "+v"(a[12]), "+v"(a[13]), "+v"(a[14]), "+v"(a[15]))
#define ATT_KREADS(dst, t_) do { _Pragma("unroll") for (int i_ = 0; i_ < 8; ++i_) asm volatile("ds_read_b128 %0, %1 offset:%2" : "=v"(dst[i_]) : "v"(ka + (unsigned)((t_) * KTILE)), "i"((i_ >> 2) * 32 * KSTR + (i_ & 3) * 32)); } while (0)
template <int MK, int NT>
__device__ __forceinline__ void attn_task(const LAS unsigned char* Kb, const LAS unsigned char* Vb, int nt_dyn, const bf16x8 (&qr)[4], float& mrun, float& lrun, f32x16 (&o)[2], int kvrel0, int lowlim, int r32, int hi) {
    asm volatile("" : "+v"(r32), "+v"(hi));
    const unsigned ka = (unsigned)(__SIZE_TYPE__)Kb + (unsigned)(r32 * KSTR + hi * 16), va = (unsigned)(__SIZE_TYPE__)Vb + (unsigned)(r32 * VSTR + hi * 8);
    bf16x8 kf[8];
    f32x16 negm = f32x16{};
    asm volatile("s_waitcnt lgkmcnt(0)" ::: "memory");
    ATT_KREADS(kf, 0);
    const int nt = NT > 0 ? NT : nt_dyn;
#pragma unroll (NT > 0 ? NT : 1)
    for (int t = 0; t < nt; ++t) {
        ATT_WAIT8(0, kf);
        f32x16 p0, p1;
        if (t == 0) { p0 = f32x16{}; p1 = f32x16{}; } else { p0 = negm; p1 = negm; }
#pragma unroll
        for (int d0 = 0; d0 < 4; ++d0) { p0 = __builtin_amdgcn_mfma_f32_32x32x16_bf16(kf[d0], qr[d0], p0, 0, 0, 0); p1 = __builtin_amdgcn_mfma_f32_32x32x16_bf16(kf[4 + d0], qr[d0], p1, 0, 0, 0); }
        s16x4 vfa[8], vfb[8];
        const unsigned vat = va + (unsigned)(t * VTILE);
#pragma unroll
        for (int i = 0; i < 8; ++i) ATT_RD64(vfa[i], vat, ((i >> 1) & 3) * 32 + (i & 1) * 16);
        const bool more = (t + 1 < nt);
        if (more) ATT_KREADS(kf, t + 1);
        if (MK != MK_NONE) {
            const int dl = kvrel0 + 64 * t + 4 * hi - r32;
#pragma unroll
            for (int r = 0; r < 16; ++r) { const int e = dl + ((r & 3) + 8 * (r >> 2));
                const bool m0 = (MK == MK_CAUSAL) ? (e > 0) : ((unsigned)(e + 127) > 127u), m1 = (MK == MK_CAUSAL) ? (e + 32 > 0) : ((unsigned)(e + 32 + 127) > 127u);
                if (m0) p0[r] = MASKED; if (m1) p1[r] = MASKED; }
            if (MK == MK_BAND && lowlim > -1000000) {
                const int d2 = kvrel0 + 64 * t + 4 * hi - lowlim;
#pragma unroll
                for (int r = 0; r < 16; ++r) { const int e = d2 + ((r & 3) + 8 * (r >> 2)); if (e < 0) p0[r] = MASKED; if (e + 32 < 0) p1[r] = MASKED; }
            }
        }
        float rm0 = __builtin_fmaxf(p0[0], p1[0]), rm1 = __builtin_fmaxf(p0[1], p1[1]), rm2 = __builtin_fmaxf(p0[2], p1[2]), rm3 = __builtin_fmaxf(p0[3], p1[3]);
#pragma unroll
        for (int r = 4; r < 16; r += 4) { rm0 = __builtin_fmaxf(__builtin_fmaxf(rm0, p0[r]), p1[r]); rm1 = __builtin_fmaxf(__builtin_fmaxf(rm1, p0[r + 1]), p1[r + 1]);
            rm2 = __builtin_fmaxf(__builtin_fmaxf(rm2, p0[r + 2]), p1[r + 2]); rm3 = __builtin_fmaxf(__builtin_fmaxf(rm3, p0[r + 3]), p1[r + 3]); }
        float rm = __builtin_fmaxf(__builtin_fmaxf(rm0, rm1), __builtin_fmaxf(rm2, rm3));
        rm = fmaxf(rm, __shfl_xor(rm, 32));
        if (t == 0) {
            const float mn = fmaxf(mrun, rm), alpha = __builtin_amdgcn_exp2f(mrun - mn); mrun = mn;
            p0 = p0 - mn; p1 = p1 - mn; lrun *= alpha; o[0] *= alpha; o[1] *= alpha;
#pragma unroll
            for (int r = 0; r < 16; ++r) negm[r] = -mn;
        } else if (__ballot(rm > 8.0f) != 0ull) {
            const float dl = fmaxf(rm, 0.f), f = __builtin_amdgcn_exp2f(-dl); mrun += dl;
            p0 = p0 - dl; p1 = p1 - dl; lrun *= f; o[0] *= f; o[1] *= f;
#pragma unroll
            for (int r = 0; r < 16; ++r) negm[r] = -mrun;
        }
        asm volatile("" : "+v"(p0), "+v"(p1));
#pragma unroll
        for (int r = 0; r < 16; ++r) { p0[r] = __builtin_amdgcn_exp2f(p0[r]); p1[r] = __builtin_amdgcn_exp2f(p1[r]); }
        asm volatile("" : "+v"(p0), "+v"(p1));
        float ls0 = p0[0] + p1[0], ls1 = p0[1] + p1[1], ls2 = p0[2] + p1[2], ls3 = p0[3] + p1[3];
#pragma unroll
        for (int r = 4; r < 16; r += 4) { ls0 += p0[r] + p1[r]; ls1 += p0[r + 1] + p1[r + 1]; ls2 += p0[r + 2] + p1[r + 2]; ls3 += p0[r + 3] + p1[r + 3]; }
        lrun += (ls0 + ls1) + (ls2 + ls3);
        bf16x8 pb[4];
#pragma unroll
        for (int s4 = 0; s4 < 4; ++s4) { const f32x16& pp = (s4 < 2) ? p0 : p1; const int r0 = 8 * (s4 & 1); u32x4 w;
            w.x = cvt_pk_bf16(pp[r0], pp[r0 + 1]); w.y = cvt_pk_bf16(pp[r0 + 2], pp[r0 + 3]); w.z = cvt_pk_bf16(pp[r0 + 4], pp[r0 + 5]); w.w = cvt_pk_bf16(pp[r0 + 6], pp[r0 + 7]); pb[s4] = __builtin_bit_cast(bf16x8, w); }
        if (more) ATT_WAIT8(8, vfa); else ATT_WAIT8(0, vfa);
#pragma unroll
        for (int i = 0; i < 8; ++i) ATT_RD64(vfb[i], vat, 32 * VSTR + ((i >> 1) & 3) * 32 + (i & 1) * 16);
#pragma unroll
        for (int s = 0; s < 4; ++s) { const s16x4 lo = vfa[s * 2], hi4 = vfa[s * 2 + 1];
            const bf16x8 av = (bf16x8){lo[0], lo[1], lo[2], lo[3], hi4[0], hi4[1], hi4[2], hi4[3]};
            o[0] = __builtin_amdgcn_mfma_f32_32x32x16_bf16(av, pb[s], o[0], 0, 0, 0); }
        ATT_WAIT8(0, vfb);
#pragma unroll
        for (int s = 0; s < 4; ++s) { const s16x4 lo = vfb[s * 2], hi4 = vfb[s * 2 + 1];
            const bf16x8 av = (bf16x8){lo[0], lo[1], lo[2], lo[3], hi4[0], hi4[1], hi4[2], hi4[3]};
            o[1] = __builtin_amdgcn_mfma_f32_32x32x16_bf16(av, pb[s], o[1], 0, 0, 0); }
    }
}
__device__ __forceinline__ void store_o(bf16* rowp, const f32x16 (&o)[2], float inv, int hi, bool valid) {
#pragma unroll
    for (int dh = 0; dh < 2; ++dh)
#pragma unroll
        for (int gp = 0; gp < 2; ++gp) {
            u32x2 we, wo;
            we.x = cvt_pk_bf16(o[dh][8 * gp] * inv, o[dh][8 * gp + 1] * inv); we.y = cvt_pk_bf16(o[dh][8 * gp + 2] * inv, o[dh][8 * gp + 3] * inv);
            wo.x = cvt_pk_bf16(o[dh][8 * gp + 4] * inv, o[dh][8 * gp + 5] * inv); wo.y = cvt_pk_bf16(o[dh][8 * gp + 6] * inv, o[dh][8 * gp + 7] * inv);
            const u32x2 keep = hi ? wo : we, send = hi ? we : wo;
            u32x2 recv; recv.x = (unsigned)__shfl_xor((int)send.x, 32); recv.y = (unsigned)__shfl_xor((int)send.y, 32);
            const u32x4 out = hi ? (u32x4){recv.x, recv.y, keep.x, keep.y} : (u32x4){keep.x, keep.y, recv.x, recv.y};
            if (valid) *(u32x4*)(rowp + dh * 32 + 8 * (2 * gp + hi)) = out;
        }
}

__device__ __forceinline__ void swa_phase(LAS unsigned char* lds, const bf16* Q, const bf16* K, const bf16* Vt, bf16* O, const float* sinks, int bx, int G, int tid) {
    const int lane = tid & 63, r32 = lane & 31, hi = lane >> 5; const int wid = __builtin_amdgcn_readfirstlane(tid >> 6);
    constexpr int LKB = 0, LVB = 6 * KTILE;
    const int srow = tid >> 3, sch = tid & 7;
    for (int u = bx; u < 256; u += G) {
        const int b = u >> 6, kvh = (u >> 4) & 3, qb = u & 15, q0 = qb * 256;
        const size_t rowbase = (size_t)b * SEQ;
        const int tfirst = (qb == 0) ? 2 : 0;
        bf16x8 qn[4];
        { const bf16* qp = Q + (rowbase + q0 + wid * 32 + r32) * D + (kvh * 4) * HD + hi * 8;
#pragma unroll
          for (int d0 = 0; d0 < 4; ++d0) qn[d0] = *(const bf16x8*)(qp + d0 * 16); }
        __syncthreads();
        { const bf16* kg = K + (rowbase + q0 - 128 + srow) * 256 + kvh * HD + sch * 8;
          const bf16* vg = Vt + ((size_t)((b * NKV + kvh) * HD + srow)) * SEQ + (q0 - 128) + sch * 8;
          for (int t = 0; t < 6; ++t) { u32x4 kr = (u32x4){0u, 0u, 0u, 0u}, vr = kr;
              if (t >= tfirst) { kr = *(const u32x4*)(kg + (size_t)t * 64 * 256); vr = *(const u32x4*)(vg + t * 64); }
              *(LAS u32x4*)(lds + LKB + t * KTILE + srow * KSTR + sch * 16) = kr;
              *(LAS u32x2*)(lds + LVB + t * VTILE + srow * VSTR + sch * 16) = (u32x2){vr.x, vr.y}; *(LAS u32x2*)(lds + LVB + t * VTILE + srow * VSTR + sch * 16 + 8) = (u32x2){vr.z, vr.w}; } }
        __syncthreads();
#pragma unroll 1
        for (int task = wid; task < 32; task += 8) {
            const int g = task >> 3, w = task & 7, h = kvh * 4 + g;
            bf16x8 qr[4];
#pragma unroll
            for (int d0 = 0; d0 < 4; ++d0) qr[d0] = qn[d0];
            if (task + 8 < 32) { const bf16* qp = Q + (rowbase + q0 + w * 32 + r32) * D + (h + 1) * HD + hi * 8;
#pragma unroll
                for (int d0 = 0; d0 < 4; ++d0) qn[d0] = *(const bf16x8*)(qp + d0 * 16); }
            float mrun = sinks[h] * 1.4426950408889634f, lrun = (hi == 0) ? 1.f : 0.f; f32x16 o[2]; o[0] = f32x16{}; o[1] = f32x16{};
            const int t0 = (w >> 1) < 2 ? (w >> 1) : 2, kvrel_base = 64 * t0 - 128 - 32 * w, lowlim = (qb == 0) ? -(32 * w) : -2000000;
            { int ta = t0 + (w >= 6 ? 1 : 0), cnt = 3;
              if (ta < tfirst) { cnt -= tfirst - ta; ta = tfirst; }
              attn_task<MK_BAND, 0>(lds + LKB + ta * KTILE, lds + LVB + ta * VTILE, cnt, qr, mrun, lrun, o, kvrel_base + 64 * (ta - t0), lowlim, r32, hi); }
            const float lt = lrun + __shfl_xor(lrun, 32);
            store_o(O + (rowbase + q0 + w * 32 + r32) * D + h * HD, o, 1.0f / lt, hi, true);
        }
    }
}
}

namespace att {
constexpr int LIST_CAP = 3840, CHUNK = 4096;
__device__ __forceinline__ void moba_gate_phase(LAS unsigned char* lds, const bf16* Q, const float* kmp, unsigned* counts, unsigned* lists, int bx, int G, int tid) {
    const int lane = tid & 63, hw = tid >> 8, t256 = tid & 255;
    LAS float* km = (LAS float*)lds + hw * 1024;
    for (int up = bx; up < 32 * 15; up += G) {
        const int u = 2 * up + hw;
        const int bh = u / 15, i = 1 + (u - bh * 15), b = bh >> 4, h = bh & 15;
        __syncthreads();
        for (int t = t256; t < i * 64; t += 256) { const int j = t >> 6, d = t & 63; const float* p = kmp + (size_t)((b * 16 + j) * 2) * 1024 + h * HD + d; km[t] = (p[0] + p[1024]) * (1.0f / 256.0f); }
        __syncthreads();
        {
            const int s = i * 256 + t256;
            const bf16* qp = Q + ((size_t)b * SEQ + s) * D + h * HD;
            float g[16];
#pragma unroll
            for (int j = 0; j < 16; ++j) g[j] = 0.f;
#pragma unroll
            for (int dc = 0; dc < 8; ++dc) {
                const bf16x8 qv = *(const bf16x8*)(qp + dc * 8); float qf[8];
#pragma unroll
                for (int e = 0; e < 8; ++e) qf[e] = bf2f((unsigned short)qv[e]);
#pragma unroll
                for (int j = 0; j < 15; ++j) if (j < i) { const LAS f32x4* kp = (const LAS f32x4*)(km + j * 64 + dc * 8); const f32x4 k0 = kp[0], k1 = kp[1];
                    g[j] += (qf[0] * k0[0] + qf[1] * k0[1]) + (qf[2] * k0[2] + qf[3] * k0[3]) + (qf[4] * k1[0] + qf[5] * k1[1]) + (qf[6] * k1[2] + qf[7] * k1[3]); }
            }
            unsigned sel = 0u; int sj0 = -1, sj1 = -1;
            const int nsel = i < 3 ? i : 3;
#pragma unroll
            for (int t = 0; t < 3; ++t) if (t < nsel) {
                float best = -3.0e38f; int bi = 0;
#pragma unroll
                for (int j = 0; j < 15; ++j) { const bool ok = (j < i) && !((sel >> j) & 1u) && (g[j] > best); best = ok ? g[j] : best; bi = ok ? j : bi; }
                sel |= 1u << bi; if (t == 0) sj0 = bi; if (t == 1) sj1 = bi;
            }
            unsigned mycnt = 0u, rk0 = 0u, rk1 = 0u, rk2 = 0u; int sj2 = -1;
            for (int j = 0; j < i; ++j) {
                const bool has = (sel >> j) & 1u;
                const unsigned long long mask = __ballot(has);
                const unsigned below = (unsigned)__popcll(mask & ((1ull << lane) - 1ull));
                if (lane == j) mycnt = (unsigned)__popcll(mask);
                if (has) { if (j == sj0) rk0 = below; else if (j == sj1) rk1 = below; else { rk2 = below; sj2 = j; } }
            }
            unsigned base = 0u;
            if (lane < i && mycnt != 0u) base = atomicAdd(&counts[lane * 64 + bh], mycnt);
            const unsigned b0 = (unsigned)__shfl((int)base, sj0 < 0 ? 0 : sj0), b1 = (unsigned)__shfl((int)base, sj1 < 0 ? 0 : sj1), b2 = (unsigned)__shfl((int)base, sj2 < 0 ? 0 : sj2);
            if (sj0 >= 0) lists[(size_t)(sj0 * 64 + bh) * LIST_CAP + b0 + rk0] = (unsigned)s | (1u << 12);
            if (sj1 >= 0) lists[(size_t)(sj1 * 64 + bh) * LIST_CAP + b1 + rk1] = (unsigned)s | (2u << 12);
            if (sj2 >= 0) lists[(size_t)(sj2 * 64 + bh) * LIST_CAP + b2 + rk2] = (unsigned)s | (3u << 12);
        }
    }
}
__device__ __forceinline__ void moba_sparse_phase(LAS unsigned char* lds, const bf16* Q, const bf16* K, const bf16* Vt, bf16* PO0, bf16* PO3, float* PL, const unsigned* counts, const unsigned* lists, int bx, int G, int tid) {
    const int lane = tid & 63, r32 = lane & 31, hi = lane >> 5; const int wid = __builtin_amdgcn_readfirstlane(tid >> 6);
    constexpr int BUFB = 4 * KTILE + 4 * VTILE, LPFX = 2 * BUFB, LCNT = LPFX + 1032 * 4, LWT = LCNT + 1024 * 4;
    LAS unsigned* pfx = (LAS unsigned*)(lds + LPFX); LAS unsigned* cnt = (LAS unsigned*)(lds + LCNT); LAS unsigned* wtot = (LAS unsigned*)(lds + LWT);
    __syncthreads();
    { const unsigned n0 = counts[2 * tid], n1 = counts[2 * tid + 1]; cnt[2 * tid] = n0; cnt[2 * tid + 1] = n1;
      const unsigned c0 = (((n0 + 31u) & ~31u) + 256u + CHUNK - 1) / CHUNK, c1 = (((n1 + 31u) & ~31u) + 256u + CHUNK - 1) / CHUNK; unsigned inc = c0 + c1;
#pragma unroll
      for (int o = 1; o < 64; o <<= 1) { const unsigned t = (unsigned)__shfl_up((int)inc, o); if (lane >= o) inc += t; }
      if (lane == 63) wtot[wid] = inc;
      __syncthreads();
      unsigned off = 0u;
#pragma unroll
      for (int w = 0; w < 8; ++w) if (w < wid) off += wtot[w];
      inc += off; pfx[2 * tid] = inc - c0 - c1; pfx[2 * tid + 1] = inc - c1; if (tid == 511) pfx[1024] = inc;
      __syncthreads(); }
    const int NTOT = (int)__builtin_amdgcn_readfirstlane((int)pfx[1024]);
    const int srow = tid >> 3, sch = tid & 7;
#define DECODE(k_, li_, c_) do { const unsigned e_ = (unsigned)__builtin_amdgcn_readfirstlane((int)utab[(k_)]); li_ = (int)(e_ & 0xffffu); c_ = (int)(e_ >> 16); } while (0)
#define KV_ISSUE(bh_, j_) do { const bf16* kg_ = K + ((size_t)((bh_) >> 4) * SEQ + (j_) * 256 + srow) * D + ((bh_) & 15) * HD + sch * 8; \
        const bf16* vg_ = Vt + ((size_t)((bh_) * HD + srow)) * SEQ + (j_) * 256 + sch * 8; \
        _Pragma("unroll") for (int t = 0; t < 4; ++t) { kreg[t] = *(const u32x4*)(kg_ + (size_t)t * 64 * D); vreg[t] = *(const u32x4*)(vg_ + t * 64); } } while (0)
#define KV_COMMIT(buf_) do { _Pragma("unroll") for (int t = 0; t < 4; ++t) { LAS unsigned char* kb_ = lds + (buf_) * BUFB + t * KTILE + srow * KSTR + sch * 16; LAS unsigned char* vb_ = lds + (buf_) * BUFB + 4 * KTILE + t * VTILE + srow * VSTR + sch * 16; \
        *(LAS u32x4*)kb_ = kreg[t]; *(LAS u32x2*)vb_ = (u32x2){vreg[t].x, vreg[t].y}; *(LAS u32x2*)(vb_ + 8) = (u32x2){vreg[t].z, vreg[t].w}; } } while (0)
    const unsigned jt_ = ((bx >> 6) == 0) ? 0xec70u : ((bx >> 6) == 1) ? 0xf961u : ((bx >> 6) == 2) ? 0xdb42u : 0xa853u;
    const bool fixed_deal = (G == 256) && (NTOT == 1024);
#define UNIT_OF(k_) (fixed_deal ? (((k_) < 4) ? (int)((jt_ >> (4 * (k_))) & 15u) * 64 + (bx & 63) : NTOT) : ((k_) * G + (((k_) & 1) ? G - 1 - bx : bx)))
    { LAS unsigned* utab_w = (LAS unsigned*)(lds + LWT + 64);
#pragma unroll
      for (int q = 0; q < 2; ++q) { const int li_ = 2 * tid + q; const int lo_ = (int)pfx[li_], hi_ = (int)pfx[li_ + 1];
          for (int k_ = 0; k_ * G < NTOT && k_ < 64; ++k_) { const int u_ = UNIT_OF(k_); if (u_ >= lo_ && u_ < hi_) utab_w[k_] = (unsigned)li_ | ((unsigned)(u_ - lo_) << 16); } }
      __syncthreads(); }
    const LAS unsigned* utab = (const LAS unsigned*)(lds + LWT + 64);
    int u = UNIT_OF(0); if (u >= NTOT) return;
    int li, c; DECODE(0, li, c);
    { u32x4 kreg[4], vreg[4]; KV_ISSUE(li & 63, li >> 6); KV_COMMIT(0); }
    int bh, j, h, n, n32, ntasks, i0; size_t rowbase; unsigned e_cur, e_nxt; bf16x8 qn[4];
#define ENTRY(task_) (((task_) >= ntasks) ? 0u : ((i0 + (task_) * 32 >= n32) ? (unsigned)(j * 256 + (i0 + (task_) * 32 - n32) + r32) \
                                              : lists[(size_t)li * LIST_CAP + ((i0 + (task_) * 32 + r32) < n ? (i0 + (task_) * 32 + r32) : n - 1)]))
#define UNIT_SETUP() do { bh = li & 63; j = li >> 6; h = bh & 15; rowbase = (size_t)(bh >> 4) * SEQ; \
        n = (int)__builtin_amdgcn_readfirstlane((int)cnt[li]); n32 = (n + 31) & ~31; \
        { const int len_ = n32 + 256, nch_ = (len_ + CHUNK - 1) / CHUNK, csz_ = (((len_ >> 5) + nch_ - 1) / nch_) << 5;       \
          int nhere_ = len_ - c * csz_; nhere_ = nhere_ > csz_ ? csz_ : nhere_; ntasks = nhere_ >> 5; i0 = c * csz_; } \
        e_cur = ENTRY(wid); e_nxt = ENTRY(wid + 8); \
        if (wid < ntasks) { const bf16* qp_ = Q + (rowbase + (e_cur & 4095u)) * D + h * HD + hi * 8; \
            _Pragma("unroll") for (int d0 = 0; d0 < 4; ++d0) qn[d0] = *(const bf16x8*)(qp_ + d0 * 16); } } while (0)
    UNIT_SETUP();
    __syncthreads();
    for (int k = 0; u < NTOT; ++k, u = UNIT_OF(k)) {
        const int un = UNIT_OF(k + 1); const bool has_next = un < NTOT;
        int li2 = 0, c2 = 0; if (has_next) DECODE(k + 1, li2, c2);
        const LAS unsigned char* Kb = lds + (k & 1) * BUFB; const LAS unsigned char* Vb = Kb + 4 * KTILE;
#pragma unroll 1
        for (int task = wid; task < ntasks; task += 8) {
            bf16x8 qr[4];
#pragma unroll
            for (int d0 = 0; d0 < 4; ++d0) qr[d0] = qn[d0];
            const unsigned e_me = e_cur; e_cur = e_nxt; e_nxt = ENTRY(task + 16);
            const int s = (int)(e_me & 4095u), slot = (int)(e_me >> 12);
            const int ti = i0 + task * 32;
            const bool ownt = ti >= n32, valid = ownt || (ti + r32) < n;
            if (task + 8 < ntasks) { const bf16* qp = Q + (rowbase + (e_cur & 4095u)) * D + h * HD + hi * 8;
#pragma unroll
                for (int d0 = 0; d0 < 4; ++d0) qn[d0] = *(const bf16x8*)(qp + d0 * 16); }
            float mrun = MINIT, lrun = 0.f; f32x16 o[2]; o[0] = f32x16{}; o[1] = f32x16{};
            if (ownt) { const int ow = (ti - n32) >> 5; attn_task<MK_CAUSAL, 0>(Kb, Vb, ((ow * 32 + 31) >> 6) + 1, qr, mrun, lrun, o, -32 * ow, 0, r32, hi); }
            else attn_task<MK_NONE, 4>(Kb, Vb, 4, qr, mrun, lrun, o, 0, 0, r32, hi);
            const float lt = lrun + __shfl_xor(lrun, 32);
            store_o(((slot < 3) ? PO0 + (size_t)slot * M * D : PO3) + (rowbase + s) * D + h * HD, o, 1.0f / lt, hi, valid);
            if (valid && hi == 0) PL[((size_t)slot * M + rowbase + s) * 16 + h] = mrun + __builtin_amdgcn_logf(lt);
        }
        li = li2; c = c2;
        if (has_next) {
            u32x4 kreg[4], vreg[4]; KV_ISSUE(li & 63, li >> 6); UNIT_SETUP(); KV_COMMIT((k + 1) & 1); }
        __syncthreads();
    }
#undef ENTRY
#undef UNIT_SETUP
#undef UNIT_OF
#undef DECODE
#undef KV_ISSUE
#undef KV_COMMIT
}
__device__ __forceinline__ void moba_combine_phase(bf16* O, const bf16* PO0, const bf16* PO3, const float* PL, int gtid, int nthreads) {
    for (int idx = gtid; idx < M * 128; idx += nthreads) {
        const int row = idx >> 7, rem = idx & 127, h = rem >> 3, dc = rem & 7;
        const int qblk = (row & (SEQ - 1)) >> 8, nv = 1 + (qblk < 3 ? qblk : 3);
        float lse[4], mx = -3.0e38f;
#pragma unroll
        for (int s = 0; s < 4; ++s) { lse[s] = (s < nv) ? PL[((size_t)s * M + row) * 16 + h] : -3.0e38f; mx = fmaxf(mx, lse[s]); }
        float acc[8], wsum = 0.f;
#pragma unroll
        for (int e = 0; e < 8; ++e) acc[e] = 0.f;
#pragma unroll
        for (int s = 0; s < 4; ++s) if (s < nv) {
            const float w = __builtin_amdgcn_exp2f(lse[s] - mx); wsum += w;
            const bf16x8 v = *(const bf16x8*)(((s < 3) ? PO0 + (size_t)s * M * D : PO3) + (size_t)row * D + h * HD + dc * 8);
#pragma unroll
            for (int e = 0; e < 8; ++e) acc[e] += w * bf2f((unsigned short)v[e]);
        }
        const float inv = 1.0f / wsum;
        u32x4 w; w.x = cvt_pk_bf16(acc[0] * inv, acc[1] * inv); w.y = cvt_pk_bf16(acc[2] * inv, acc[3] * inv); w.z = cvt_pk_bf16(acc[4] * inv, acc[5] * inv); w.w = cvt_pk_bf16(acc[6] * inv, acc[7] * inv);
        *(u32x4*)(O + (size_t)row * D + h * HD + dc * 8) = w;
    }
}
}

__device__ __forceinline__ void conv_fix_phase(bf16* ACT, const bf16* head, const bf16* tail, const float* cw, const float* cb, int gtid, int nthreads) {
    constexpr int NCG = DFF / 8, NST = M / 64;
    for (int it = gtid; it < NCG * NST * 2; it += nthreads) {
        const int rk = it / NCG, cgi = it - rk * NCG, c = cgi * 8, k = rk & 1, st = rk >> 1;
        const bool bstart = (st & 63) == 0;
        const bf16* p0 = head + (size_t)(st * 2 + k) * DFF2 + c;
        const bf16* p1 = (k == 1) ? head + (size_t)(st * 2) * DFF2 + c : tail + (size_t)((st - 1) * 2 + 1) * DFF2 + c;
        const bf16* p2 = tail + (size_t)((st - 1) * 2 + k) * DFF2 + c;
        const bool z1 = bstart && (k == 0), z2 = bstart;
        const bf16x8 zero = (bf16x8){0, 0, 0, 0, 0, 0, 0, 0};
        const bf16x8 g0 = *(const bf16x8*)p0, v0 = *(const bf16x8*)(p0 + DFF);
        const bf16x8 g1 = z1 ? zero : *(const bf16x8*)p1, v1 = z1 ? zero : *(const bf16x8*)(p1 + DFF);
        const bf16x8 g2 = z2 ? zero : *(const bf16x8*)p2, v2 = z2 ? zero : *(const bf16x8*)(p2 + DFF);
        float r[8];
#pragma unroll
        for (int h2 = 0; h2 < 2; ++h2) {
            const int cc = c + 4 * h2;
            const f32x4 wg0 = *(const f32x4*)(cw + cc), wg1 = *(const f32x4*)(cw + DFF2 + cc), wg2 = *(const f32x4*)(cw + 2 * DFF2 + cc), bgv = *(const f32x4*)(cb + cc);
            const f32x4 wv0 = *(const f32x4*)(cw + DFF + cc), wv1 = *(const f32x4*)(cw + DFF2 + DFF + cc), wv2 = *(const f32x4*)(cw + 2 * DFF2 + DFF + cc), bvv = *(const f32x4*)(cb + DFF + cc);
#pragma unroll
            for (int j = 0; j < 4; ++j) { const int e = 4 * h2 + j;
                const float gc = bgv[j] + wg0[j] * bf2f((unsigned short)g2[e]) + wg1[j] * bf2f((unsigned short)g1[e]) + wg2[j] * bf2f((unsigned short)g0[e]);
                const float vc = bvv[j] + wv0[j] * bf2f((unsigned short)v2[e]) + wv1[j] * bf2f((unsigned short)v1[e]) + wv2[j] * bf2f((unsigned short)v0[e]);
                r[e] = gc * __builtin_amdgcn_rcpf(1.0f + __builtin_amdgcn_exp2f(-gc * 1.4426950408889634f)) * vc; }
        }
        u32x4 w; w.x = cvt_pk_bf16(r[0], r[1]); w.y = cvt_pk_bf16(r[2], r[3]); w.z = cvt_pk_bf16(r[4], r[5]); w.w = cvt_pk_bf16(r[6], r[7]);
        *(u32x4*)(ACT + (size_t)(st * 64 + k) * DFF + c) = w;
    }
}

#define GAS __attribute__((address_space(1)))
#define XB_TMO      128
#define XB_XCNT(j)  (256  + 64 * (j))
#define XB_XSUB(j)  (1280 + 64 * (j))
#define XB_XGEN(j)  (2304 + 64 * (j))
#define XB_TOP      3328
#define XB_TOPGEN   3392
#define XCD_BAR_WORDS 3456
#define XB_SPIN_CAP (1u << 18)

__device__ __forceinline__ unsigned xb_ld(unsigned* p)              { return __hip_atomic_load(p, __ATOMIC_RELAXED, __HIP_MEMORY_SCOPE_AGENT); }
__device__ __forceinline__ unsigned xb_add(unsigned* p, unsigned v) { return __hip_atomic_fetch_add(p, v, __ATOMIC_RELAXED, __HIP_MEMORY_SCOPE_AGENT); }
__device__ __forceinline__ unsigned xb_xcc_id() { return (unsigned)__builtin_amdgcn_s_getreg((3 << 11) | 20) & 0xFu; }
#define XB_SPIN(cond, bar) do { unsigned _sp = 0; while (cond) { __builtin_amdgcn_s_sleep(1); \
    if ((++_sp & 255u) == 0u) { if (xb_ld(&(bar)[XB_TMO])) break; if (_sp > XB_SPIN_CAP) { atomicAdd(&(bar)[XB_TMO], 1u); break; } } } } while (0)

struct XcdBarrier {
    unsigned* bar; unsigned x;
    volatile LAS unsigned* st;
};

__device__ __forceinline__ XcdBarrier xcd_barrier_post(unsigned* bar, volatile LAS unsigned* st, const int tid_) {
    XcdBarrier b; b.bar = bar; b.x = xb_xcc_id(); b.st = st;
    if (tid_ == 0) (void)xb_add(&bar[XB_XCNT(b.x)], 1u);
    return b;
}
__device__ __forceinline__ void xcd_barrier_complete(unsigned* bar, unsigned x, unsigned& nloc, unsigned& nx) {
    const unsigned G = gridDim.x * gridDim.y * gridDim.z;
    unsigned sum, cnt, mine, sp = 0u;
    for (;;) {
        sum = 0u; cnt = 0u; mine = 0u;
#pragma unroll
        for (unsigned j = 0; j < 16; ++j) { const unsigned c = xb_ld(&bar[XB_XCNT(j)]); sum += c; cnt += (c > 0u) ? 1u : 0u; mine = (j == x) ? c : mine; }
        if (sum == G) break;
        __builtin_amdgcn_s_sleep(1);
        if ((++sp & 255u) == 0u) { if (xb_ld(&bar[XB_TMO])) break; if (sp > XB_SPIN_CAP) { atomicAdd(&bar[XB_TMO], 1u); break; } }
    }
    nloc = mine > 0u ? mine : 1u; nx = cnt > 0u ? cnt : 1u;
}

__device__ __forceinline__ void xcd_barrier(const XcdBarrier& b, const int tid_) {
    asm volatile("s_waitcnt vmcnt(0)" ::: "memory");
    __syncthreads();
    if (tid_ == 0) {
        unsigned* bar = b.bar;
        __builtin_amdgcn_s_waitcnt(0);
        unsigned nloc = b.st[0], nx = b.st[1];
        if (nloc == 0u) { xcd_barrier_complete(bar, b.x, nloc, nx); b.st[0] = nloc; b.st[1] = nx; }
        const unsigned old = xb_add(&bar[XB_XSUB(b.x)], 1u);
        const unsigned gen = old / nloc;
        if (old + 1u == (gen + 1u) * nloc) {
            __builtin_amdgcn_fence(__ATOMIC_RELEASE, "agent");
            asm volatile("s_waitcnt vmcnt(0)" ::: "memory");
            const unsigned og = xb_add(&bar[XB_TOP], 1u);
            const unsigned tg = og / nx;
            if (og + 1u == (tg + 1u) * nx) xb_add(&bar[XB_TOPGEN], 1u);
            else XB_SPIN(xb_ld(&bar[XB_TOPGEN]) == tg, bar);
            __builtin_amdgcn_fence(__ATOMIC_ACQUIRE, "agent");
            xb_add(&bar[XB_XGEN(b.x)], 1u);
            asm volatile("s_waitcnt vmcnt(0)" ::: "memory");
        } else {
            XB_SPIN(xb_ld(&bar[XB_XGEN(b.x)]) == gen, bar);
            __builtin_amdgcn_fence(__ATOMIC_ACQUIRE, "agent");
            asm volatile("s_waitcnt vmcnt(0)" ::: "memory");
        }
    }
    __syncthreads();
}

__device__ __forceinline__ int mk_wave(int w) { asm volatile("" : "+s"(w)); return w; }
__device__ __forceinline__ int mk_lane() { int l; asm volatile("v_mbcnt_lo_u32_b32 %0, -1, 0\n\tv_mbcnt_hi_u32_b32 %0, -1, %0" : "=v"(l)); return l; }
#define PROBE_DUP_KINDS 0
#define PROBE_DUP_LAYERS 15
#define PROBE_XSYNC 0
#define PROBE_REPS(ph) (((((ph) >= 1 && (ph) <= 32) && ((PROBE_DUP_KINDS >> (((ph) - 1) % 8)) & 1)) || ((ph) == 0 && (PROBE_DUP_KINDS & 256))) && ((PROBE_DUP_LAYERS >> (((ph) - 1) / 8)) & 1) ? 2 : 1)
__global__ void __launch_bounds__(NWAVES * 64) yoco_fwd(Args a_kernarg) {
    extern __shared__ __attribute__((aligned(16))) unsigned char lds_raw[];
    cg::grid_group grid = cg::this_grid();
    LAS unsigned char* lds = (LAS unsigned char*)lds_raw;
    const int G0 = gridDim.x, bx0 = blockIdx.x;
    volatile LAS unsigned* MISC = (volatile LAS unsigned*)(lds + LDS_BYTES - 512);
    unsigned* barw = (unsigned*)a_kernarg.ws;
    const int wave_s = __builtin_amdgcn_readfirstlane((int)threadIdx.x >> 6);
#define MK_TID() ((mk_wave(wave_s) << 6) | mk_lane())
    { const int t0 = MK_TID(); if (t0 < 64) MISC[t0] = 0u;
    }
    __syncthreads();
    (void)xcd_barrier_post(barw, MISC + 8, MK_TID());
    const int lo = a_kernarg.ph_lo, hi = a_kernarg.ph_hi;
    for (int ph = lo; ph < hi; ++ph) {
    for (int rep = 0; rep < PROBE_REPS(ph); ++rep) {
    int G = G0, bx = bx0; asm volatile("" : "+s"(G), "+s"(bx));
    const int vcu = (G % 8 == 0) ? (bx % 8) * (G / 8) + bx / 8 : bx;
    ArgsP ap = (ArgsP)__builtin_amdgcn_kernarg_segment_ptr(); asm volatile("" : "+s"(ap));
    unsigned char* ws = a.ws;
    float* ssq = (float*)(ws + WS_SSQ); const float* cs = (const float*)(ws + WS_CS); float* kmp = (float*)(ws + WS_KMP);
    bf16* xb = (bf16*)(ws + WS_XB); bf16* QO = (bf16*)(ws + WS_QO); bf16* Kb = (bf16*)(ws + WS_K); bf16* VT = (bf16*)(ws + WS_VT);
    bf16* KS = (bf16*)(ws + WS_KS); bf16* VTS = (bf16*)(ws + WS_VTS); bf16* U = (bf16*)(ws + WS_U); bf16* HALO = (bf16*)(ws + WS_HALO); bf16* OB = (bf16*)(ws + WS_O);
    {
        if (ph == 0) {
            prologue(ap, lds, vcu * NWAVES + mk_wave(wave_s), G * NWAVES, mk_lane());
        } else if (ph == 33) {
            const int gw = vcu * NWAVES + mk_wave(wave_s), NGW = G * NWAVES; const int lane = mk_lane();
            f32x4 gv[4];
#pragma unroll
            for (int j = 0; j < 4; ++j) gv[j] = *((const f32x4*)a.final_norm + lane + 64 * j);
#define FIN_RSTD(m_) ({ const f32x4* sp_ = (const f32x4*)(ssq + (size_t)(m_) * 16); const f32x4 s0 = sp_[0], s1 = sp_[1], s2 = sp_[2], s3 = sp_[3]; \
                1.0f / sqrtf((((s0[0] + s0[1]) + (s0[2] + s0[3])) + ((s1[0] + s1[1]) + (s1[2] + s1[3])) + ((s2[0] + s2[1]) + (s2[2] + s2[3])) + ((s3[0] + s3[1]) + (s3[2] + s3[3]))) * (1.0f / D) + 1e-6f); })
#define FIN_ROW(m_, H_, R_) do { f32x4* xr_ = (f32x4*)(a.out + (size_t)(m_) * D) + lane; \
                _Pragma("unroll") for (int j = 0; j < 4; ++j) { const unsigned long long h_ = H_[j]; f32x4 v_; \
                    v_[0] = bf2f((unsigned short)(h_ & 0xffffu)); v_[1] = bf2f((unsigned short)((h_ >> 16) & 0xffffu)); v_[2] = bf2f((unsigned short)((h_ >> 32) & 0xffffu)); v_[3] = bf2f((unsigned short)(h_ >> 48)); \
                    xr_[64 * j] = v_ * (R_) * gv[j]; } } while (0)
#define FIN_LOAD(m_, H_) do { const unsigned long long* hr_ = (const unsigned long long*)((const bf16*)(ws + WS_XH2) + (size_t)(m_) * D) + lane; \
                _Pragma("unroll") for (int j = 0; j < 4; ++j) H_[j] = hr_[64 * j]; } while (0)
            int m0 = gw;
            for (; m0 + NGW < M; m0 += 2 * NGW) {
                unsigned long long ha[4], hb[4];
                FIN_LOAD(m0, ha); FIN_LOAD(m0 + NGW, hb);
                const float ra = FIN_RSTD(m0), rb = FIN_RSTD(m0 + NGW);
                FIN_ROW(m0, ha, ra); FIN_ROW(m0 + NGW, hb, rb);
            }
            for (; m0 < M; m0 += NGW) { unsigned long long ha[4]; FIN_LOAD(m0, ha); const float ra = FIN_RSTD(m0); FIN_ROW(m0, ha, ra); }
#undef FIN_RSTD
#undef FIN_ROW
#undef FIN_LOAD
        } else {
            const int l = (ph - 1) / 8, kind = (ph - 1) % 8;
            if (l >= 2 && (kind == 1 || kind == 3)) continue;
            unsigned* counts = (unsigned*)(ws + WS_COUNTS); unsigned* lists = (unsigned*)(ws + WS_LISTS);
            bf16* PO0 = (bf16*)(ws + WS_PO0); bf16* PO3 = (bf16*)a.out + (size_t)M * D; float* PL = (float*)(ws + WS_PL);
            if (kind == 0) {
                if (l < 2 && bx == 0) { unsigned z = 0u; asm volatile("" : "+v"(z)); counts[2 * MK_TID()] = z; counts[2 * MK_TID() + 1] = z; counts[1024 + 2 * MK_TID()] = z; counts[1025 + 2 * MK_TID()] = z; }
                pg8::Gemm g; pg8::EpiQKV E;
                E.ssq = ssq; E.cs = cs; E.qscale = C2; E.Q = QO;
                if (l < 2) { g = pg8::Gemm{xb, (const bf16*)(ws + WS_WQKV) + (size_t)l * 3 * D * D, M, 3 * D, D, D}; E.Kd = Kb; E.Vt = VT; E.kmp = kmp; E.nQ = 4; E.nK = 4; E.kpitch = 1024; }
                else if (l == 2) { g = pg8::Gemm{xb, (const bf16*)(ws + WS_WQ2), M, 1536, D, D}; E.Kd = KS; E.Vt = VTS; E.kmp = nullptr; E.nQ = 4; E.nK = 1; E.kpitch = 256; }
                else { g = pg8::Gemm{xb, (const bf16*)(ws + WS_WQ3), M, D, D, D}; E.Kd = KS; E.Vt = VTS; E.kmp = nullptr; E.nQ = 4; E.nK = 1; E.kpitch = 256; }
                pg8::StaticOrder S; S.init(M, g.N, G, bx);
                pg8::gemm_phase<pg8::EpiQKV, pg8::StaticOrder, true, true>(lds, g, S, E, MK_TID());
            } else if (kind == 1) {
                att::moba_gate_phase(lds, QO, kmp, rep ? counts + 1024 : counts, rep ? (unsigned*)PO0 : lists, bx, G, MK_TID());
            } else if (kind == 2) {
                if (l < 2) att::moba_sparse_phase(lds, QO, Kb, VT, PO0, PO3, PL, counts, lists, bx, G, MK_TID());
                else att::swa_phase(lds, QO, KS, VTS, OB, a.sinks_b + (l - 2) * H, bx, G, MK_TID());
            } else if (kind == 3) {
                att::moba_combine_phase(QO, PO0, PO3, PL, bx * 512 + MK_TID(), G * 512);
            } else if (kind == 4 || kind == 7) {
                pg8::Gemm g; pg8::EpiResid E;
                if (kind == 4) g = pg8::Gemm{(l < 2) ? QO : OB, (const bf16*)(ws + WS_WO) + (size_t)l * D * D, M, D, D, D};
                else g = pg8::Gemm{U, (const bf16*)(ws + WS_WDN) + (size_t)l * D * DFF, M, D, DFF, DFF};
                const bool lastg = (l == 3 && kind == 7);
                E.hin = xb; E.lin = (const bf16*)a.out; E.hout = lastg ? (bf16*)(ws + WS_XH2) : xb; E.lout = lastg ? (bf16*)(ws + WS_XL2) : (bf16*)a.out; E.ssq = ssq;
                pg8::StaticOrder S; S.init(M, D, G, bx);
                pg8::gemm_phase<pg8::EpiResid, pg8::StaticOrder, true, true>(lds, g, S, E, MK_TID());
            } else if (kind == 5) {
                pg8::Gemm g{xb, (const bf16*)(ws + WS_WUP) + (size_t)l * DFF2 * D, M, DFF2, D, D};
                pg8::EpiUpConv E{U, HALO, HALO + (size_t)(M / 64) * 2 * DFF2, ssq, a.conv_w + (size_t)l * 3 * DFF2, a.conv_b + (size_t)l * DFF2};
                pg8::StaticOrder S; S.init(M, DFF2, G, bx);
                pg8::gemm_phase<pg8::EpiUpConv, pg8::StaticOrder, true, true>(lds, g, S, E, MK_TID());
                if (l < 3) {
                    const int nun = (M / 256) * (DFF2 / 256), rem = nun % G;
                    const bool idle = (rem != 0) && (bx >= rem);
                    if (idle || rem == 0) { const int widx = (rem != 0) ? bx - rem : bx, nwk = (rem != 0) ? G - rem : G;
                        convert_layer(ap, lds, l + 1, widx * NWAVES + mk_wave(wave_s), nwk * NWAVES, mk_wave(wave_s), mk_lane()); }
                }
            } else {
                conv_fix_phase(U, HALO, HALO + (size_t)(M / 64) * 2 * DFF2, a.conv_w + (size_t)l * 3 * DFF2, a.conv_b + (size_t)l * DFF2, bx * 512 + MK_TID(), G * 512);
            }
        }
        if (ph + 1 < hi || rep + 1 < PROBE_REPS(ph)) { if (lo < 0) grid.sync();        XcdBarrier bar; bar.bar = (unsigned*)ws; bar.x = xb_xcc_id(); bar.st = MISC + 8; xcd_barrier(bar, MK_TID()); }
    }
    }
    }
}
#undef a

extern "C" void kernel_launch(void* const* d_in, const int* in_sizes, int n_in, void* d_out, int out_size, void* d_ws, size_t ws_size, hipStream_t stream) {
    static int grid = 0;
    if (grid == 0) {
        if (n_in != 16 || out_size != M * D || ws_size < WS_END) { fprintf(stderr, "kernel_launch: unexpected shapes n_in %d out %d ws %zu\n", n_in, out_size, ws_size); grid = -1; return; }
        int dev = 0, cus = 0, per_cu = 0;
        hipGetDevice(&dev); hipDeviceGetAttribute(&cus, hipDeviceAttributeMultiprocessorCount, dev);
        if (hipFuncSetAttribute((const void*)yoco_fwd, hipFuncAttributeMaxDynamicSharedMemorySize, LDS_BYTES) != hipSuccess) { fprintf(stderr, "kernel_launch: hipFuncSetAttribute failed\n"); grid = -1; return; }
        if (hipOccupancyMaxActiveBlocksPerMultiprocessor(&per_cu, (const void*)yoco_fwd, NWAVES * 64, LDS_BYTES) != hipSuccess || per_cu < 1) { fprintf(stderr, "kernel_launch: occupancy query failed (%d)\n", per_cu); per_cu = 1; (void)hipGetLastError(); }
        grid = cus * per_cu;
    }
    if (grid < 0) return;
    Args a{};
    a.x = (const float*)d_in[0]; a.pos = (const int*)d_in[1]; a.attn_norm = (const float*)d_in[2]; a.w_qkv_a = (const float*)d_in[3]; a.w_o_a = (const float*)d_in[4];
    a.kv_norm = (const float*)d_in[5]; a.w_kv_b = (const float*)d_in[6]; a.w_q_b = (const float*)d_in[7]; a.sinks_b = (const float*)d_in[8]; a.w_o_b = (const float*)d_in[9];
    a.ffn_norm = (const float*)d_in[10]; a.w_up = (const float*)d_in[11]; a.conv_w = (const float*)d_in[12]; a.conv_b = (const float*)d_in[13]; a.w_down = (const float*)d_in[14];
    a.final_norm = (const float*)d_in[15]; a.out = (float*)d_out; a.ws = (unsigned char*)d_ws;
    a.ph_lo = 0; a.ph_hi = 34;
    if (hipMemsetAsync(d_ws, 0, 16384, stream) != hipSuccess) { fprintf(stderr, "kernel_launch: hipMemsetAsync of the barrier words failed\n"); return; }
    void* args[] = {&a};
    hipError_t e = hipLaunchCooperativeKernel((const void*)yoco_fwd, dim3(grid), dim3(NWAVES * 64), args, LDS_BYTES, stream);
    if (e != hipSuccess) fprintf(stderr, "cooperative launch failed: %s (grid %d)\n", hipGetErrorString(e), grid);
}
```

```cpp
#include <hip/hip_runtime.h>
#include <hip/hip_cooperative_groups.h>
#include <cstdio>
#include <cstdint>
namespace cg = cooperative_groups;
__device__ __forceinline__ int pg8_lane_now() { int l; asm volatile("v_mbcnt_lo_u32_b32 %0, -1, 0\n\tv_mbcnt_hi_u32_b32 %0, -1, %0" : "=v"(l)); return l; }
namespace pg8 {
#define PG8_LAS __attribute__((address_space(3)))
typedef unsigned short bf16_t;
typedef short bf16x8 __attribute__((ext_vector_type(8)));
typedef float f32x4 __attribute__((ext_vector_type(4)));
typedef unsigned u32x4 __attribute__((ext_vector_type(4)));
constexpr int BM = 256, BK = 64, HALF = 128, HTB = HALF * BK * 2  , STAGE_BYTES = 8 * HTB, NXCD = 8, WGM = 4;

__host__ __device__ __forceinline__ int lds_byte(int r, int c) { const int st = (r >> 4) * 2 + (c >> 5), rr = r & 15, cc = c & 31, ob = rr * 64 + cc * 2; return st * 1024 + (ob ^ (((ob >> 9) & 1) << 5)); }
__host__ __device__ __forceinline__ void stage_rc(int b, int& R, int& C) { const int st = b / 1024, sb = b % 1024, swz = sb ^ (((sb >> 9) & 1) << 5); R = (st >> 1) * 16 + swz / 64; C = (st & 1) * 32 + (swz % 64) / 2; }
__host__ __device__ __forceinline__ int perm32(int rho) { const int n = rho >> 4, i = rho & 15; return 8 * (i >> 2) + 4 * n + (i & 3); }

struct Unit { int pm, pn; };
struct Gemm { const bf16_t* A; const bf16_t* Bt; int M, N, K, lda; };

struct StaticOrder {
    int nM, nN, nwg, G, c;
    __host__ __device__ void init(int M, int N, int G_, int c_) { nM = M / BM; nN = N / BM; nwg = nM * nN; G = G_; c = c_; }
    __host__ __device__ bool next(int i, Unit& u) const {
        const long L = (long)i * G + c; if (L >= nwg) return false;
        int wgid = (int)L; { const int q = nwg / NXCD, r = nwg % NXCD, xcd = wgid % NXCD, off = wgid / NXCD; wgid = (xcd < r ? xcd * (q + 1) : r * (q + 1) + (xcd - r) * q) + off; }
        const int nig = WGM * nN, gid = wgid / nig, fm = gid * WGM, gsz = (nM - fm) < WGM ? (nM - fm) : WGM;
        u.pm = fm + ((wgid % nig) % gsz); u.pn = (wgid % nig) / gsz; return true;
    }
    __device__ __forceinline__ void a_ready(const Unit&) const {}
    __device__ __forceinline__ void done(const Unit&) const {}
};

typedef float f32x2 __attribute__((ext_vector_type(2)));
typedef __bf16 bf16x2_t __attribute__((ext_vector_type(2)));
typedef unsigned u32x2 __attribute__((ext_vector_type(2)));
__device__ __forceinline__ unsigned cvt_pk_bf16(float lo, float hi) { f32x2 v = {lo, hi}; bf16x2_t b = __builtin_convertvector(v, bf16x2_t); return __builtin_bit_cast(unsigned, b); }
constexpr float RMS_EPS = 1e-6f;
__device__ __forceinline__ void row_rstd(const float* ssq, int row0, int fq, float (&rs)[2][4]) {
#pragma unroll
    for (int ai = 0; ai < 2; ++ai)
#pragma unroll
        for (int m = 0; m < 4; ++m) { const f32x4 p = *(const f32x4*)(ssq + (size_t)(row0 + ai * HALF + m * 16) * 16 + fq * 4);
            float s = (p[0] + p[1]) + (p[2] + p[3]); s += __shfl_xor(s, 16); s += __shfl_xor(s, 32); rs[ai][m] = 1.0f / sqrtf(s * (1.0f / 1024.0f) + RMS_EPS); }
}
struct EpiQKV {
    static constexpr bool PERM = true, AFTER_DRAIN = false;
    bf16_t* Q; bf16_t* Kd; bf16_t* Vt; const float* ssq; const float* cs; float* kmp; int nQ, nK, kpitch; float qscale;
    __device__ __forceinline__ void operator()(const f32x4 (&acc)[2][2][4][2], const Unit& u, int wr, int wc, int fr, int fq) const {
        const int row0 = u.pm * BM + wr * 64 + fr;
        float rs[2][4]; row_rstd(ssq, row0, fq, rs);
        const int type = u.pn < nQ ? 0 : (u.pn < nQ + nK ? 1 : 2);
        const bool rope = (type != 2) && ((wc & 1) == 0);
        const float sgn = (fq == 0) ? -1.f : 1.f; const bool rl = fq < 2;
        const int colw = wc * 32 + 8 * fq;
        f32x4 ks[2][2];
#pragma unroll
        for (int bj = 0; bj < 2; ++bj) { ks[bj][0] = (f32x4){0.f, 0.f, 0.f, 0.f}; ks[bj][1] = (f32x4){0.f, 0.f, 0.f, 0.f}; }
#pragma unroll
        for (int ai = 0; ai < 2; ++ai)
#pragma unroll
            for (int m = 0; m < 4; ++m) {
                const int row = row0 + ai * HALF + m * 16;
                f32x4 c0, c1, s0, s1;
                if (rope) { const f32x4* cp = (const f32x4*)(cs + (size_t)row * 16); c0 = cp[0]; c1 = cp[1]; s0 = cp[2]; s1 = cp[3]; }
                const float r_ = rs[ai][m] * (type == 0 ? qscale : 1.f);
#pragma unroll
                for (int bj = 0; bj < 2; ++bj) {
                    f32x4 v0 = acc[ai][bj][m][0], v1 = acc[ai][bj][m][1];
                    if (rope) {
                        f32x4 o0, o1;
#pragma unroll
                        for (int j = 0; j < 4; ++j) { o0[j] = __shfl_xor(v0[j], 16); o1[j] = __shfl_xor(v1[j], 16); }
                        if (rl) { v0 = v0 * c0 + (o0 * s0) * sgn; v1 = v1 * c1 + (o1 * s1) * sgn; }
                    }
                    v0 = v0 * r_; v1 = v1 * r_;
                    if (type == 2) {
                        const int b = row >> 12, s = row & 4095;
                        const int col = (u.pn - nQ - nK) * BM + bj * HALF + colw;
                        bf16_t* vp = Vt + ((size_t)(b * kpitch + col) * 4096 + s);
                        const unsigned w0 = cvt_pk_bf16(v0[0], v0[1]), w1 = cvt_pk_bf16(v0[2], v0[3]), w2 = cvt_pk_bf16(v1[0], v1[1]), w3 = cvt_pk_bf16(v1[2], v1[3]);
                        vp[0 * 4096] = (bf16_t)(w0 & 0xffffu); vp[1 * 4096] = (bf16_t)(w0 >> 16); vp[2 * 4096] = (bf16_t)(w1 & 0xffffu); vp[3 * 4096] = (bf16_t)(w1 >> 16);
                        vp[4 * 4096] = (bf16_t)(w2 & 0xffffu); vp[5 * 4096] = (bf16_t)(w2 >> 16); vp[6 * 4096] = (bf16_t)(w3 & 0xffffu); vp[7 * 4096] = (bf16_t)(w3 >> 16);
                    } else {
                        u32x4 w; w.x = cvt_pk_bf16(v0[0], v0[1]); w.y = cvt_pk_bf16(v0[2], v0[3]); w.z = cvt_pk_bf16(v1[0], v1[1]); w.w = cvt_pk_bf16(v1[2], v1[3]);
                        if (type == 0) *(u32x4*)(Q + (size_t)row * 1024 + u.pn * BM + bj * HALF + colw) = w;
                        else { *(u32x4*)(Kd + (size_t)row * kpitch + (u.pn - nQ) * BM + bj * HALF + colw) = w; ks[bj][0] += v0; ks[bj][1] += v1; }
                    }
                }
            }
        if (type == 1 && kmp) {
#pragma unroll
            for (int bj = 0; bj < 2; ++bj)
#pragma unroll
                for (int n = 0; n < 2; ++n) {
                    f32x4 v = ks[bj][n];
#pragma unroll
                    for (int j = 0; j < 4; ++j) { float t = v[j]; t += __shfl_xor(t, 1); t += __shfl_xor(t, 2); t += __shfl_xor(t, 4); t += __shfl_xor(t, 8); v[j] = t; }
                    if (fr == 0) *(f32x4*)(kmp + ((size_t)(u.pm * 2 + wr) * 1024) + (u.pn - nQ) * BM + bj * HALF + colw + 4 * n) = v;
                }
        }
    }
};
__device__ __forceinline__ float conv_ror1(float x) { float r; asm volatile("v_mov_b32_dpp %0, %1 row_ror:1 row_mask:0xf bank_mask:0xf" : "=v"(r) : "v"(x)); return r; }
__device__ __forceinline__ float conv_ror2(float x) { float r; asm volatile("v_mov_b32_dpp %0, %1 row_ror:2 row_mask:0xf bank_mask:0xf" : "=v"(r) : "v"(x)); return r; }
#define CONV_ROR(x_, n_) ((n_) == 1 ? conv_ror1(x_) : conv_ror2(x_))
struct EpiUpConv {
    static constexpr bool PERM = true, AFTER_DRAIN = false;
    bf16_t* ACT; bf16_t* head; bf16_t* tail; const float* ssq; const float* cw; const float* cb;
    __device__ __forceinline__ void operator()(const f32x4 (&acc)[2][2][4][2], const Unit& u, int wr, int wc, int fr, int fq) const {
        asm volatile("" : "+v"(fr), "+v"(fq));
        const int row0 = u.pm * BM + wr * 64 + fr;
        float rs[2][4]; row_rstd(ssq, row0, fq, rs);
        const int src1 = (fq << 4) | ((fr - 1) & 15), src2 = (fq << 4) | ((fr - 2) & 15);
        const int ch0 = u.pn * HALF + wc * 32 + 8 * fq;
#pragma unroll
        for (int n = 0; n < 2; ++n) {
            asm volatile("" ::: "memory");
            const int ch = ch0 + 4 * n;
            const f32x4 wg0 = *(const f32x4*)(cw + ch), wg1 = *(const f32x4*)(cw + 5632 + ch), wg2 = *(const f32x4*)(cw + 2 * 5632 + ch), bgv = *(const f32x4*)(cb + ch);
            const f32x4 wv0 = *(const f32x4*)(cw + 2816 + ch), wv1 = *(const f32x4*)(cw + 5632 + 2816 + ch), wv2 = *(const f32x4*)(cw + 2 * 5632 + 2816 + ch), bvv = *(const f32x4*)(cb + 2816 + ch);
#pragma unroll
            for (int ai = 0; ai < 2; ++ai) {
                f32x4 g1p = (f32x4){0.f, 0.f, 0.f, 0.f}, g2p = g1p, v1p = g1p, v2p = g1p;
#pragma unroll
                for (int m = 0; m < 4; ++m) {
                    const int row = row0 + ai * HALF + m * 16;
                    f32x4 ug = acc[ai][0][m][n] * rs[ai][m], uv = acc[ai][1][m][n] * rs[ai][m];
                    asm volatile("s_nop 1" : "+v"(ug), "+v"(uv));
                    f32x4 g1, g2, v1, v2;
#pragma unroll
                    for (int j = 0; j < 4; ++j) { g1[j] = CONV_ROR(ug[j], 1); g2[j] = CONV_ROR(ug[j], 2); v1[j] = CONV_ROR(uv[j], 1); v2[j] = CONV_ROR(uv[j], 2); }
                    const f32x4 gp1 = fr >= 1 ? g1 : g1p, gp2 = fr >= 2 ? g2 : g2p, vp1 = fr >= 1 ? v1 : v1p, vp2 = fr >= 2 ? v2 : v2p;
                    const f32x4 gc = bgv + wg0 * gp2 + wg1 * gp1 + wg2 * ug, vc = bvv + wv0 * vp2 + wv1 * vp1 + wv2 * uv;
                    f32x4 r;
#pragma unroll
                    for (int j = 0; j < 4; ++j) r[j] = gc[j] * __builtin_amdgcn_rcpf(1.0f + __builtin_amdgcn_exp2f(-gc[j] * 1.4426950408889634f)) * vc[j];
                    const bool boundary = (m == 0) && (fr < 2);
                    if (!boundary) { u32x2 w; w.x = cvt_pk_bf16(r[0], r[1]); w.y = cvt_pk_bf16(r[2], r[3]); *(u32x2*)(ACT + (size_t)row * 2816 + ch) = w; }
                    if (boundary || (m == 3 && fr >= 14)) {
                        u32x2 a, b; a.x = cvt_pk_bf16(ug[0], ug[1]); a.y = cvt_pk_bf16(ug[2], ug[3]); b.x = cvt_pk_bf16(uv[0], uv[1]); b.y = cvt_pk_bf16(uv[2], uv[3]);
                        bf16_t* dst = (boundary ? head : tail) + ((size_t)(row >> 6) * 2 + (boundary ? fr : fr - 14)) * 5632 + ch;
                        *(u32x2*)dst = a; *(u32x2*)(dst + 2816) = b;
                    }
                    g1p = g1; g2p = g2; v1p = v1; v2p = v2;
                }
            }
        }
    }
};
#ifndef RESID_LO
#define RESID_LO 0
#endif
struct EpiResid {
    static constexpr bool PERM = true, AFTER_DRAIN = false;
    const bf16_t* hin; const bf16_t* lin; bf16_t* hout; bf16_t* lout; float* ssq;
    __device__ __forceinline__ void operator()(const f32x4 (&acc)[2][2][4][2], const Unit& u, int wr, int wc, int fr, int fq) const {
        const int row0 = u.pm * BM + wr * 64 + fr; const int col0 = u.pn * BM + wc * 32 + 8 * fq;
        u32x4 hq[3][2], lq[3][2];
#define RES_LOAD(slot_, g_) do { const size_t off_ = (size_t)(row0 + ((g_) >> 2) * HALF + ((g_) & 3) * 16) * 1024 + col0; \
        _Pragma("unroll") for (int q_ = 0; q_ < 2; ++q_) { hq[slot_][q_] = *(const u32x4*)(hin + off_ + q_ * HALF); if (RESID_LO) lq[slot_][q_] = *(const u32x4*)(lin + off_ + q_ * HALF); } } while (0)
#define RES_UNPK(w_, e_) (((e_) & 1) ? __builtin_bit_cast(float, (w_)[(e_) >> 1] & 0xffff0000u) : __builtin_bit_cast(float, (w_)[(e_) >> 1] << 16))
        RES_LOAD(0, 0); RES_LOAD(1, 1);
#pragma unroll
        for (int g = 0; g < 8; ++g) {
            const int ai = g >> 2, m = g & 3;
            if (g + 2 < 8) RES_LOAD((g + 2) % 3, g + 2);
            const int row = row0 + ai * HALF + m * 16; const size_t off = (size_t)row * 1024 + col0; float ss = 0.f;
#pragma unroll
            for (int bj = 0; bj < 2; ++bj) {
                const u32x4 hv = hq[g % 3][bj];
                float xv[8];
#pragma unroll
                for (int e = 0; e < 8; ++e) { float x0 = RES_UNPK(hv, e); if (RESID_LO) { const u32x4 lv = lq[g % 3][bj]; x0 += RES_UNPK(lv, e); } xv[e] = x0 + acc[ai][bj][m][e >> 2][e & 3]; ss += xv[e] * xv[e]; }
                u32x4 w, wl;
#pragma unroll
                for (int e2 = 0; e2 < 4; ++e2) { w[e2] = cvt_pk_bf16(xv[2 * e2], xv[2 * e2 + 1]);
                    wl[e2] = cvt_pk_bf16(xv[2 * e2] - __builtin_bit_cast(float, w[e2] << 16), xv[2 * e2 + 1] - __builtin_bit_cast(float, w[e2] & 0xffff0000u)); }
                *(u32x4*)(hout + off + bj * HALF) = w; if (RESID_LO) *(u32x4*)(lout + off + bj * HALF) = wl;
            }
            ss += __shfl_xor(ss, 16); ss += __shfl_xor(ss, 32);
            if (fq == 0) ssq[(size_t)row * 16 + u.pn * 4 + wc] = ss;
        }
#undef RES_LOAD
#undef RES_UNPK
    }
};

template <class Epi, class Sched, bool ALIGN_EPI = false, bool SP2 = false>
__device__ __forceinline__ void gemm_phase(PG8_LAS unsigned char* lds, const Gemm g, const Sched& S, const Epi& E, const int tid) {
    const int wid = __builtin_amdgcn_readfirstlane(tid >> 6), lane = tid & 63, wr = wid >> 2, wc = wid & 3, fr = lane & 15, fq = lane >> 4;
    const int K = g.K, nt = K / BK, lda = g.lda;
    unsigned voffA[2], voffB[2];
#pragma unroll
    for (int i = 0; i < 2; ++i) { int R, C; stage_rc(tid * 16 + i * 8192, R, C); const int Rb = Epi::PERM ? ((R & ~31) + perm32(R & 31)) : R;
        voffA[i] = (unsigned)(R * lda + C) * 2u; voffB[i] = (unsigned)(Rb * K + C) * 2u; }
    const size_t kstep = (size_t)(BK * 2);
    const size_t hstep = (size_t)HALF * K * 2;
    const size_t tstep = 2 * hstep; const size_t hstepA = (size_t)HALF * lda * 2, tstepA = 2 * hstepA;
    const unsigned ldsw = (unsigned)wid * 1024u;
    const int aoff = lds_byte(wr * 64 + fr, fq * 8), boff = lds_byte(wc * 32 + fr, fq * 8);
#define PG8_SA(b, h) (((b) * 2 + (h)) * HTB)
#define PG8_SB(b, h) ((4 + (b) * 2 + (h)) * HTB)
#define PG8_STAGE(bufoff, gbase, voff) do { _Pragma("unroll") for (int _i = 0; _i < 2; ++_i) \
        __builtin_amdgcn_global_load_lds((const unsigned*)((const char*)(gbase) + (voff)[_i]), (PG8_LAS unsigned*)(lds + (bufoff) + ldsw + _i * 8192), 16, 0, 0); } while (0)
#define PG8_LDA(dst, b, h) do { _Pragma("unroll") for (int m = 0; m < 4; ++m) _Pragma("unroll") for (int k = 0; k < 2; ++k) dst[m][k] = *(const PG8_LAS bf16x8*)(lds + PG8_SA(b, h) + aoff + m * 2048 + k * 1024); } while (0)
#define PG8_LDB(dst, b, h) do { _Pragma("unroll") for (int n = 0; n < 2; ++n) _Pragma("unroll") for (int k = 0; k < 2; ++k) dst[n][k] = *(const PG8_LAS bf16x8*)(lds + PG8_SB(b, h) + boff + n * 2048 + k * 1024); } while (0)
#define PG8_MMA(ai, bj, At, Bt) do { __builtin_amdgcn_s_setprio(1); _Pragma("unroll") for (int m = 0; m < 4; ++m) _Pragma("unroll") for (int n = 0; n < 2; ++n) _Pragma("unroll") for (int k = 0; k < 2; ++k) \
        acc[ai][bj][m][n] = __builtin_amdgcn_mfma_f32_16x16x32_bf16(Bt[n][k], At[m][k], acc[ai][bj][m][n], 0, 0, 0); __builtin_amdgcn_s_setprio(0); } while (0)
#define PG8_WAIT_V(n) asm volatile("s_waitcnt vmcnt(" #n ")" ::: "memory")
#define PG8_WAIT_L(n) asm volatile("s_waitcnt lgkmcnt(" #n ")" ::: "memory")
#define PG8_BAR __builtin_amdgcn_s_barrier()
#define PG8_SCHED __builtin_amdgcn_sched_barrier(0)
    Unit cur, nxt; int ui = 0;
    if (!S.next(0, cur)) return;
    f32x4 acc[2][2][4][2];
#pragma unroll
    for (int a = 0; a < 2; ++a)
#pragma unroll
        for (int b = 0; b < 2; ++b)
#pragma unroll
            for (int m = 0; m < 4; ++m)
#pragma unroll
                for (int n = 0; n < 2; ++n) acc[a][b][m][n] = (f32x4){0.f, 0.f, 0.f, 0.f};
    bf16x8 At[4][2], B0[2][2], B1[2][2];
    const char* cA = (const char*)g.A + (size_t)cur.pm * tstepA; const char* cB = (const char*)g.Bt + (size_t)cur.pn * tstep;
    S.a_ready(cur);
    if constexpr (SP2) {
        PG8_STAGE(PG8_SB(0, 0), cB, voffB); PG8_STAGE(PG8_SB(0, 1), cB + hstep, voffB); PG8_STAGE(PG8_SA(0, 0), cA, voffA); PG8_STAGE(PG8_SA(0, 1), cA + hstepA, voffA);
        if (wr == 1) PG8_BAR;
        PG8_WAIT_V(2); PG8_BAR;
        PG8_STAGE(PG8_SB(1, 0), cB + kstep, voffB); PG8_STAGE(PG8_SA(1, 0), cA + kstep, voffA); PG8_STAGE(PG8_SB(1, 1), cB + hstep + kstep, voffB);
        PG8_WAIT_V(6); PG8_BAR;
    } else {
        PG8_STAGE(PG8_SB(0, 0), cB, voffB); PG8_STAGE(PG8_SA(0, 0), cA, voffA); PG8_STAGE(PG8_SB(0, 1), cB + hstep, voffB); PG8_STAGE(PG8_SA(0, 1), cA + hstepA, voffA);
        if (wr == 1) PG8_BAR;
        PG8_WAIT_V(4); PG8_BAR;
        PG8_STAGE(PG8_SB(1, 0), cB + kstep, voffB); PG8_STAGE(PG8_SA(1, 0), cA + kstep, voffA); PG8_STAGE(PG8_SB(1, 1), cB + hstep + kstep, voffB);
        PG8_WAIT_V(6); PG8_BAR;
    }
    for (;;) {
        const bool has_next = S.next(ui + 1, nxt);
        const char* nA = has_next ? (const char*)g.A + (size_t)nxt.pm * tstepA : cA; const char* nB = has_next ? (const char*)g.Bt + (size_t)nxt.pn * tstep : cB;
        for (int t = 0; t < nt; t += 2) {
            const bool last = (t == nt - 2);
            const char* a1 = cA + (size_t)(t + 1) * kstep;
            const char* a2 = last ? nA : cA + (size_t)(t + 2) * kstep; const char* b2 = last ? nB : cB + (size_t)(t + 2) * kstep;
            const char* a3 = a2 + kstep; const char* b3 = b2 + kstep;
            if (last && has_next) S.a_ready(nxt);
            if constexpr (SP2) {
            PG8_LDB(B0, 0, 0); PG8_LDB(B1, 0, 1); PG8_SCHED; PG8_LDA(At, 0, 0); PG8_STAGE(PG8_SA(1, 1), a1 + hstepA, voffA);
            PG8_WAIT_V(8); PG8_WAIT_L(0); PG8_BAR; PG8_MMA(0, 0, At, B0); PG8_MMA(0, 1, At, B1); PG8_BAR; PG8_SCHED;
            PG8_LDA(At, 0, 1); PG8_STAGE(PG8_SB(0, 0), b2, voffB); PG8_STAGE(PG8_SB(0, 1), b2 + hstep, voffB); PG8_STAGE(PG8_SA(0, 0), a2, voffA);
            PG8_WAIT_V(8); PG8_WAIT_L(0); PG8_BAR; PG8_MMA(1, 0, At, B0); PG8_MMA(1, 1, At, B1); PG8_BAR; PG8_SCHED;
            PG8_LDB(B0, 1, 0); PG8_LDB(B1, 1, 1); PG8_SCHED; PG8_LDA(At, 1, 0); PG8_STAGE(PG8_SA(0, 1), a2 + hstepA, voffA);
            PG8_WAIT_V(8); PG8_WAIT_L(0); PG8_BAR; PG8_MMA(0, 0, At, B0); PG8_MMA(0, 1, At, B1); PG8_BAR; PG8_SCHED;
            PG8_LDA(At, 1, 1); PG8_STAGE(PG8_SB(1, 0), b3, voffB); PG8_STAGE(PG8_SB(1, 1), b3 + hstep, voffB); PG8_STAGE(PG8_SA(1, 0), a3, voffA);
            PG8_WAIT_V(8); PG8_WAIT_L(0); PG8_BAR; PG8_MMA(1, 0, At, B0); PG8_MMA(1, 1, At, B1); PG8_BAR; PG8_SCHED;
            } else {
            PG8_LDB(B0, 0, 0); PG8_SCHED; PG8_LDA(At, 0, 0); PG8_STAGE(PG8_SA(1, 1), a1 + hstepA, voffA);
            PG8_WAIT_L(8); PG8_BAR; PG8_WAIT_L(0); PG8_MMA(0, 0, At, B0); PG8_BAR; PG8_SCHED;
            PG8_LDB(B1, 0, 1); PG8_STAGE(PG8_SB(0, 0), b2, voffB);
            PG8_BAR; PG8_WAIT_L(0); PG8_MMA(0, 1, At, B1); PG8_BAR;
            PG8_LDA(At, 0, 1); PG8_STAGE(PG8_SA(0, 0), a2, voffA);
            PG8_BAR; PG8_WAIT_L(0); PG8_MMA(1, 0, At, B0); PG8_BAR; PG8_SCHED;
            PG8_STAGE(PG8_SB(0, 1), b2 + hstep, voffB);
            PG8_WAIT_V(6); PG8_BAR; PG8_MMA(1, 1, At, B1); PG8_BAR;
            PG8_LDB(B0, 1, 0); PG8_SCHED; PG8_LDA(At, 1, 0); PG8_STAGE(PG8_SA(0, 1), a2 + hstepA, voffA);
            PG8_WAIT_L(8); PG8_BAR; PG8_WAIT_L(0); PG8_MMA(0, 0, At, B0); PG8_BAR; PG8_SCHED;
            PG8_LDB(B1, 1, 1); PG8_STAGE(PG8_SB(1, 0), b3, voffB);
            PG8_BAR; PG8_WAIT_L(0); PG8_MMA(0, 1, At, B1); PG8_BAR;
            PG8_LDA(At, 1, 1); PG8_STAGE(PG8_SA(1, 0), a3, voffA);
            PG8_BAR; PG8_WAIT_L(0); PG8_MMA(1, 0, At, B0); PG8_BAR; PG8_SCHED;
            PG8_STAGE(PG8_SB(1, 1), b3 + hstep, voffB);
            PG8_WAIT_V(6); PG8_BAR; PG8_MMA(1, 1, At, B1); PG8_BAR;
            }
        }
        if constexpr (ALIGN_EPI) { if (wr == 0) PG8_BAR; }
        if constexpr (!Epi::AFTER_DRAIN) { const int l2_ = pg8_lane_now(); E(acc, cur, wr, wc, l2_ & 15, l2_ >> 4); S.done(cur); }
        if (!has_next) break;
#pragma unroll
        for (int a = 0; a < 2; ++a)
#pragma unroll
            for (int b = 0; b < 2; ++b)
#pragma unroll
                for (int m = 0; m < 4; ++m)
#pragma unroll
                    for (int n = 0; n < 2; ++n) acc[a][b][m][n] = (f32x4){0.f, 0.f, 0.f, 0.f};
        cur = nxt; cA = nA; cB = nB; ++ui;
        if constexpr (ALIGN_EPI) { if (wr == 1) PG8_BAR; }
    }
    PG8_WAIT_V(0);
    if constexpr (!ALIGN_EPI) { if (wr == 0) PG8_BAR; }
    PG8_BAR;
    if constexpr (Epi::AFTER_DRAIN) { E.fused(acc, cur, wr, wc, fr, fq, lds, wid, lane); S.done(cur); }
#undef PG8_SA
#undef PG8_SB
#undef PG8_STAGE
#undef PG8_LDA
#undef PG8_LDB
#undef PG8_MMA
#undef PG8_WAIT_V
#undef PG8_WAIT_L
#undef PG8_BAR
#undef PG8_SCHED
}
}

#define LAS __attribute__((address_space(3)))
typedef unsigned short bf16;
typedef short bf16x8 __attribute__((ext_vector_type(8)));
typedef short s16x4 __attribute__((ext_vector_type(4)));
typedef float f32x4 __attribute__((ext_vector_type(4)));
typedef float f32x16 __attribute__((ext_vector_type(16)));
typedef unsigned u32x4 __attribute__((ext_vector_type(4)));
typedef unsigned u32x2 __attribute__((ext_vector_type(2)));
constexpr int NWAVES = 8;
constexpr int BATCH = 4, SEQ = 4096, D = 1024, H = 16, HD = 64, NKV = 4, DFF = 2816, DFF2 = 5632, M = BATCH * SEQ;
constexpr float C2 = 0.125f * 1.4426950408889634f;
constexpr size_t MiB = 1u << 20;
constexpr size_t WS_CS = 1 * MiB, WS_SSQ = 2 * MiB, WS_KMP = 3 * MiB;
constexpr size_t WS_WQKV = 4 * MiB;
constexpr size_t WS_WO = 16 * MiB;
constexpr size_t WS_WQ2 = 24 * MiB;
constexpr size_t WS_WQ3 = 27 * MiB;
constexpr size_t WS_WUP = 29 * MiB;
constexpr size_t WS_WDN = 73 * MiB;
constexpr size_t WS_XB = 96 * MiB;
constexpr size_t WS_KS = 128 * MiB;
constexpr size_t WS_VTS = 136 * MiB;
constexpr size_t WS_QO = 144 * MiB, WS_K = 176 * MiB, WS_VT = 208 * MiB;
constexpr size_t WS_O = 240 * MiB;
constexpr size_t WS_U = 144 * MiB;
constexpr size_t WS_HALO = 320 * MiB;
constexpr size_t WS_PO0 = 240 * MiB;
constexpr size_t WS_XH2 = 240 * MiB, WS_XL2 = 272 * MiB;
constexpr size_t WS_PL = 336 * MiB;
constexpr size_t WS_LISTS = 128 * MiB;
constexpr size_t WS_COUNTS = 32768;
constexpr size_t WS_END = 340 * MiB;
constexpr int LDS_BYTES = 163840;

__device__ __forceinline__ float wave_sum(float v) {
#pragma unroll
    for (int o = 1; o < 64; o <<= 1) v += __shfl_xor(v, o);
    return v;
}
__device__ __forceinline__ float bf2f(unsigned short b) { return __builtin_bit_cast(float, (unsigned)b << 16); }
using pg8::cvt_pk_bf16;

__device__ __forceinline__ void transpose_item(const float* W, const float* g, int K, int N, bf16* WT, int rowoff, LAS float* scr, int item, int lane, bool gv_perm = false) {
    const int nblk = N / 32, kb = item / nblk, nb = item % nblk, k0 = 64 * kb, n0 = 32 * nb;
    const int d0 = gv_perm ? ((n0 < DFF) ? (n0 >> 7) * 256 + (n0 & 127) : ((n0 - DFF) >> 7) * 256 + 128 + ((n0 - DFF) & 127)) : rowoff + n0;
#pragma unroll
    for (int i = 0; i < 8; ++i) { const int kk = 8 * i + (lane >> 3), n4 = (lane & 7) * 4; const float gs = g ? g[k0 + kk] : 1.f;
        const f32x4 v = *(const f32x4*)(W + (size_t)(k0 + kk) * N + n0 + n4) * gs; LAS float* d = scr + kk * 33 + n4; d[0] = v[0]; d[1] = v[1]; d[2] = v[2]; d[3] = v[3]; }
    asm volatile("s_waitcnt lgkmcnt(0)" ::: "memory");
    const int c = lane & 7;
#pragma unroll
    for (int j = 0; j < 4; ++j) { const int n = (lane >> 3) + 8 * j; const LAS float* s = scr + (8 * c) * 33 + n;
        u32x4 o; o.x = cvt_pk_bf16(s[0 * 33], s[1 * 33]); o.y = cvt_pk_bf16(s[2 * 33], s[3 * 33]); o.z = cvt_pk_bf16(s[4 * 33], s[5 * 33]); o.w = cvt_pk_bf16(s[6 * 33], s[7 * 33]);
        *(u32x4*)(WT + (size_t)(d0 + n) * K + k0 + 8 * c) = o; }
    asm volatile("s_waitcnt lgkmcnt(0)" ::: "memory");
}

struct Args {
    const float* x; const int* pos; const float* attn_norm; const float* w_qkv_a; const float* w_o_a; const float* kv_norm; const float* w_kv_b; const float* w_q_b;
    const float* sinks_b; const float* w_o_b; const float* ffn_norm; const float* w_up; const float* conv_w; const float* conv_b; const float* w_down; const float* final_norm;
    float* out; unsigned char* ws; int ph_lo, ph_hi;
};

typedef const __attribute__((address_space(4))) Args* ArgsP;
#define a (*ap)
__device__ __forceinline__ void convert_layer(ArgsP ap, LAS unsigned char* lds, int l, int gw, int NGW, int wslot, int lane) {
    gw = __builtin_amdgcn_readfirstlane(gw); NGW = __builtin_amdgcn_readfirstlane(NGW);
    unsigned char* ws = a.ws;
    LAS float* scr = (LAS float*)(lds + wslot * 16384);
    constexpr int I_QKV = 16 * 96, I_SQ = 16 * 32, I_KV = 16 * 16, I_UP = 16 * 176, I_DN = 44 * 32;
    constexpr int B_SQ = 2 * I_QKV, B_KV = B_SQ + 6 * I_SQ, B_UP = B_KV + I_KV, B_DN = B_UP + 4 * I_UP;
    for (int rg = 0; rg < 5; ++rg) {
        int lo_, n_;
        if (rg == 0) { if (l < 2) { lo_ = l * I_QKV; n_ = I_QKV; } else { lo_ = B_SQ + (l + 2) * I_SQ; n_ = I_SQ; } }
        else if (rg == 1) { lo_ = B_SQ + l * I_SQ; n_ = I_SQ; }
        else if (rg == 2) { lo_ = B_UP + l * I_UP; n_ = I_UP; }
        else if (rg == 3) { lo_ = B_DN + l * I_DN; n_ = I_DN; }
        else { lo_ = B_KV; n_ = (l == 2) ? I_KV : 0; }
    for (int it = lo_ + gw; it < lo_ + n_; it += NGW) {
        int r = it;
        if (r < 2 * I_QKV) { const int l2 = r / I_QKV; r -= l2 * I_QKV;
            transpose_item(a.w_qkv_a + (size_t)l2 * D * 3 * D, a.attn_norm + l2 * D, D, 3 * D, (bf16*)(ws + WS_WQKV) + (size_t)l2 * 3 * D * D, 0, scr, r, lane); continue; } r -= 2 * I_QKV;
        if (r < 6 * I_SQ) { const int t = r / I_SQ; r -= t * I_SQ;
            const float* W; const float* g = nullptr; bf16* dst;
            if (t < 2) { W = a.w_o_a + (size_t)t * D * D; dst = (bf16*)(ws + WS_WO) + (size_t)t * D * D; }
            else if (t < 4) { W = a.w_o_b + (size_t)(t - 2) * D * D; dst = (bf16*)(ws + WS_WO) + (size_t)t * D * D; }
            else if (t == 4) { W = a.w_q_b; g = a.attn_norm + 2 * D; dst = (bf16*)(ws + WS_WQ2); }
            else { W = a.w_q_b + (size_t)D * D; g = a.attn_norm + 3 * D; dst = (bf16*)(ws + WS_WQ3); }
            transpose_item(W, g, D, D, dst, 0, scr, r, lane); continue; } r -= 6 * I_SQ;
        if (r < I_KV) { transpose_item(a.w_kv_b, a.kv_norm, D, 512, (bf16*)(ws + WS_WQ2), 1024, scr, r, lane); continue; } r -= I_KV;
        if (r < 4 * I_UP) { const int l2 = r / I_UP; r -= l2 * I_UP;
            transpose_item(a.w_up + (size_t)l2 * D * DFF2, a.ffn_norm + l2 * D, D, DFF2, (bf16*)(ws + WS_WUP) + (size_t)l2 * DFF2 * D, 0, scr, r, lane, true); continue; } r -= 4 * I_UP;
        { const int l2 = r / I_DN; r -= l2 * I_DN;
            transpose_item(a.w_down + (size_t)l2 * DFF * D, nullptr, DFF, D, (bf16*)(ws + WS_WDN) + (size_t)l2 * D * DFF, 0, scr, r, lane); }
    }
    }
}
__device__ __forceinline__ void prologue(ArgsP ap, LAS unsigned char* lds, int gw, int NGW, int lane) {
    gw = __builtin_amdgcn_readfirstlane(gw); NGW = __builtin_amdgcn_readfirstlane(NGW);
    unsigned char* ws = a.ws;
    convert_layer(ap, lds, 0, gw, NGW, gw & 7, lane);
    bf16* xb = (bf16*)(ws + WS_XB); bf16* xl = (bf16*)a.out; float* ssq = (float*)(ws + WS_SSQ);
    for (int m = gw; m < M; m += NGW) {
        const f32x4* xr = (const f32x4*)(a.x + (size_t)m * D) + lane; float s = 0.f;
        unsigned long long* o8 = (unsigned long long*)(xb + (size_t)m * D) + lane; unsigned long long* l8 = (unsigned long long*)(xl + (size_t)m * D) + lane;
#pragma unroll
        for (int j = 0; j < 4; ++j) { const f32x4 v = xr[64 * j]; s += (v[0] * v[0] + v[1] * v[1]) + (v[2] * v[2] + v[3] * v[3]);
            const unsigned h0 = cvt_pk_bf16(v[0], v[1]), h1 = cvt_pk_bf16(v[2], v[3]);
            const unsigned l0 = cvt_pk_bf16(v[0] - bf2f((unsigned short)(h0 & 0xffffu)), v[1] - bf2f((unsigned short)(h0 >> 16))), l1 = cvt_pk_bf16(v[2] - bf2f((unsigned short)(h1 & 0xffffu)), v[3] - bf2f((unsigned short)(h1 >> 16)));
            o8[64 * j] = (unsigned long long)h0 | ((unsigned long long)h1 << 32); if (RESID_LO) l8[64 * j] = (unsigned long long)l0 | ((unsigned long long)l1 << 32); }
        s = wave_sum(s);
        if (lane < 16) ssq[(size_t)m * 16 + lane] = (lane == 0) ? s : 0.f;
    }
    float* cs = (float*)(ws + WS_CS);
    const int gt = gw * 64 + lane, NT = NGW * 64;
    for (int i = gt; i < M * 8; i += NT) {
        const int m = i >> 3, k = i & 7;
        const double c1 = 0.19392274474868576, c2 = c1 * c1, c4 = c2 * c2;
        const double invf = ((k & 1) ? c1 : 1.0) * ((k & 2) ? c2 : 1.0) * ((k & 4) ? c4 : 1.0);
        const double ang = (double)a.pos[m] * invf;
        const double kk = __builtin_rint(ang * 0.15915494309189535);
        const double rr = ang - kk * 6.283185307179586;
        const float rf = (float)rr, r2 = rf * rf;
        float ts = 1.f, tc = 1.f;
#pragma unroll 1
        for (int q = 14; q >= 1; --q) { const float da = (float)((2 * q) * (2 * q + 1)), db = (float)((2 * q - 1) * (2 * q)); ts = 1.f - r2 * ts * __builtin_amdgcn_rcpf(da); tc = 1.f - r2 * tc * __builtin_amdgcn_rcpf(db); }
        cs[(size_t)m * 16 + k] = tc; cs[(size_t)m * 16 + 8 + k] = rf * ts;
    }
}

#ifndef PROBE_TASKREP
#define PROBE_TASKREP 1
#endif
#define PROBE_STOREREP 1
#define PROBE_UNITREP 1
namespace att {
constexpr int KSTR = 144, VSTR = 136;
constexpr int KTILE = 64 * KSTR, VTILE = 64 * VSTR;
__device__ __forceinline__ int crow(int r, int hi) { return (r & 3) + 8 * (r >> 2) + 4 * hi; }
constexpr float MASKED = -3.0e38f, MINIT = -1.0e30f;
enum { MK_NONE = 0, MK_CAUSAL = 1, MK_BAND = 2 };
#define ATT_RD128(dst, base, off) asm volatile("ds_read_b128 %0, %1 offset:%2" : "=v"(dst) : "v"(base), "i"(off))
#define ATT_RD64(dst, base, off) asm volatile("ds_read_b64 %0, %1 offset:%2" : "=v"(dst) : "v"(base), "i"(off))
#define ATT_WAIT8(n, a) asm volatile("s_waitcnt lgkmcnt(" #n ")" : "+v"(a[0]), "+v"(a[1]), "+v"(a[2]), "+v"(a[3]), "+v"(a[4]), "+v"(a[5]), "+v"(a[6]), "+v"(a[7]))
#define ATT_WAIT16(n, a) asm volatile("s_waitcnt lgkmcnt(" #n ")" : "+v"(a[0]), "+v"(a[1]), "+v"(a[2]), "+v"(a[3]), "+v"(a[4]), "+v"(a[5]), "+v"(a[6]), "+v"(a[7]), "+v"(a[8]), "+v"(a[9]), "+v"(a[10]), "+v"(a[11]), "+v"(a[12]), "+v"(a[13]), "+v"(a[14]), "+v"(a[15]))
#define ATT_KREADS(dst, t_) do { _Pragma("unroll") for (int i_ = 0; i_ < 8; ++i_) asm volatile("ds_read_b128 %0, %1 offset:%2" : "=v"(dst[i_]) : "v"(ka + (unsigned)((t_) * KTILE)), "i"((i_ >> 2) * 32 * KSTR + (i_ & 3) * 32)); } while (0)
template <int MK, int NT>
__device__ __forceinline__ void attn_task(const LAS unsigned char* Kb, const LAS unsigned char* Vb, int nt_dyn, const bf16x8 (&qr)[4], float& mrun, float& lrun, f32x16 (&o)[2], int kvrel0, int lowlim, int r32, int hi) {
    asm volatile("" : "+v"(r32), "+v"(hi));
    const unsigned ka = (unsigned)(__SIZE_TYPE__)Kb + (unsigned)(r32 * KSTR + hi * 16), va = (unsigned)(__SIZE_TYPE__)Vb + (unsigned)(r32 * VSTR + hi * 8);
    bf16x8 kf[8];
    f32x16 negm = f32x16{};
    asm volatile("s_waitcnt lgkmcnt(0)" ::: "memory");
    ATT_KREADS(kf, 0);
    const int nt = NT > 0 ? NT : nt_dyn;
#pragma unroll (NT > 0 ? NT : 1)
    for (int t = 0; t < nt; ++t) {
        ATT_WAIT8(0, kf);
        f32x16 p0, p1;
        if (t == 0) { p0 = f32x16{}; p1 = f32x16{}; } else { p0 = negm; p1 = negm; }
#pragma unroll
        for (int d0 = 0; d0 < 4; ++d0) { p0 = __builtin_amdgcn_mfma_f32_32x32x16_bf16(kf[d0], qr[d0], p0, 0, 0, 0); p1 = __builtin_amdgcn_mfma_f32_32x32x16_bf16(kf[4 + d0], qr[d0], p1, 0, 0, 0); }
        s16x4 vfa[8], vfb[8];
        const unsigned vat = va + (unsigned)(t * VTILE);
#pragma unroll
        for (int i = 0; i < 8; ++i) ATT_RD64(vfa[i], vat, ((i >> 1) & 3) * 32 + (i & 1) * 16);
        const bool more = (t + 1 < nt);
        if (more) ATT_KREADS(kf, t + 1);
        if (MK != MK_NONE) {
            const int dl = kvrel0 + 64 * t + 4 * hi - r32;
#pragma unroll
            for (int r = 0; r < 16; ++r) { const int e = dl + ((r & 3) + 8 * (r >> 2));
                const bool m0 = (MK == MK_CAUSAL) ? (e > 0) : ((unsigned)(e + 127) > 127u), m1 = (MK == MK_CAUSAL) ? (e + 32 > 0) : ((unsigned)(e + 32 + 127) > 127u);
                if (m0) p0[r] = MASKED; if (m1) p1[r] = MASKED; }
            if (MK == MK_BAND && lowlim > -1000000) {
                const int d2 = kvrel0 + 64 * t + 4 * hi - lowlim;
#pragma unroll
                for (int r = 0; r < 16; ++r) { const int e = d2 + ((r & 3) + 8 * (r >> 2)); if (e < 0) p0[r] = MASKED; if (e + 32 < 0) p1[r] = MASKED; }
            }
        }
        float rm0 = __builtin_fmaxf(p0[0], p1[0]), rm1 = __builtin_fmaxf(p0[1], p1[1]), rm2 = __builtin_fmaxf(p0[2], p1[2]), rm3 = __builtin_fmaxf(p0[3], p1[3]);
#pragma unroll
        for (int r = 4; r < 16; r += 4) { rm0 = __builtin_fmaxf(__builtin_fmaxf(rm0, p0[r]), p1[r]); rm1 = __builtin_fmaxf(__builtin_fmaxf(rm1, p0[r + 1]), p1[r + 1]);
            rm2 = __builtin_fmaxf(__builtin_fmaxf(rm2, p0[r + 2]), p1[r + 2]); rm3 = __builtin_fmaxf(__builtin_fmaxf(rm3, p0[r + 3]), p1[r + 3]); }
        float rm = __builtin_fmaxf(__builtin_fmaxf(rm0, rm1), __builtin_fmaxf(rm2, rm3));
        rm = fmaxf(rm, __shfl_xor(rm, 32));
        if (t == 0) {
            const float mn = fmaxf(mrun, rm), alpha = __builtin_amdgcn_exp2f(mrun - mn); mrun = mn;
            p0 = p0 - mn; p1 = p1 - mn; lrun *= alpha; o[0] *= alpha; o[1] *= alpha;
#pragma unroll
            for (int r = 0; r < 16; ++r) negm[r] = -mn;
        } else if (__ballot(rm > 8.0f) != 0ull) {
            const float dl = fmaxf(rm, 0.f), f = __builtin_amdgcn_exp2f(-dl); mrun += dl;
            p0 = p0 - dl; p1 = p1 - dl; lrun *= f; o[0] *= f; o[1] *= f;
#pragma unroll
            for (int r = 0; r < 16; ++r) negm[r] = -mrun;
        }
        asm volatile("" : "+v"(p0), "+v"(p1));
#pragma unroll
        for (int r = 0; r < 16; ++r) { p0[r] = __builtin_amdgcn_exp2f(p0[r]); p1[r] = __builtin_amdgcn_exp2f(p1[r]); }
        asm volatile("" : "+v"(p0), "+v"(p1));
        float ls0 = p0[0] + p1[0], ls1 = p0[1] + p1[1], ls2 = p0[2] + p1[2], ls3 = p0[3] + p1[3];
#pragma unroll
        for (int r = 4; r < 16; r += 4) { ls0 += p0[r] + p1[r]; ls1 += p0[r + 1] + p1[r + 1]; ls2 += p0[r + 2] + p1[r + 2]; ls3 += p0[r + 3] + p1[r + 3]; }
        lrun += (ls0 + ls1) + (ls2 + ls3);
        bf16x8 pb[4];
#pragma unroll
        for (int s4 = 0; s4 < 4; ++s4) { const f32x16& pp = (s4 < 2) ? p0 : p1; const int r0 = 8 * (s4 & 1); u32x4 w;
            w.x = cvt_pk_bf16(pp[r0], pp[r0 + 1]); w.y = cvt_pk_bf16(pp[r0 + 2], pp[r0 + 3]); w.z = cvt_pk_bf16(pp[r0 + 4], pp[r0 + 5]); w.w = cvt_pk_bf16(pp[r0 + 6], pp[r0 + 7]); pb[s4] = __builtin_bit_cast(bf16x8, w); }
        if (more) ATT_WAIT8(8, vfa); else ATT_WAIT8(0, vfa);
#pragma unroll
        for (int i = 0; i < 8; ++i) ATT_RD64(vfb[i], vat, 32 * VSTR + ((i >> 1) & 3) * 32 + (i & 1) * 16);
#pragma unroll
        for (int s = 0; s < 4; ++s) { const s16x4 lo = vfa[s * 2], hi4 = vfa[s * 2 + 1];
            const bf16x8 av = (bf16x8){lo[0], lo[1], lo[2], lo[3], hi4[0], hi4[1], hi4[2], hi4[3]};
            o[0] = __builtin_amdgcn_mfma_f32_32x32x16_bf16(av, pb[s], o[0], 0, 0, 0); }
        ATT_WAIT8(0, vfb);
#pragma unroll
        for (int s = 0; s < 4; ++s) { const s16x4 lo = vfb[s * 2], hi4 = vfb[s * 2 + 1];
            const bf16x8 av = (bf16x8){lo[0], lo[1], lo[2], lo[3], hi4[0], hi4[1], hi4[2], hi4[3]};
            o[1] = __builtin_amdgcn_mfma_f32_32x32x16_bf16(av, pb[s], o[1], 0, 0, 0); }
    }
}
__device__ __forceinline__ void store_o(bf16* rowp, const f32x16 (&o)[2], float inv, int hi, bool valid) {
#pragma unroll
    for (int dh = 0; dh < 2; ++dh)
#pragma unroll
        for (int gp = 0; gp < 2; ++gp) {
            u32x2 we, wo;
            we.x = cvt_pk_bf16(o[dh][8 * gp] * inv, o[dh][8 * gp + 1] * inv); we.y = cvt_pk_bf16(o[dh][8 * gp + 2] * inv, o[dh][8 * gp + 3] * inv);
            wo.x = cvt_pk_bf16(o[dh][8 * gp + 4] * inv, o[dh][8 * gp + 5] * inv); wo.y = cvt_pk_bf16(o[dh][8 * gp + 6] * inv, o[dh][8 * gp + 7] * inv);
            const u32x2 keep = hi ? wo : we, send = hi ? we : wo;
            u32x2 recv; recv.x = (unsigned)__shfl_xor((int)send.x, 32); recv.y = (unsigned)__shfl_xor((int)send.y, 32);
            const u32x4 out = hi ? (u32x4){recv.x, recv.y, keep.x, keep.y} : (u32x4){keep.x, keep.y, recv.x, recv.y};
            if (valid) *(u32x4*)(rowp + dh * 32 + 8 * (2 * gp + hi)) = out;
        }
}

__device__ __forceinline__ void swa_phase(LAS unsigned char* lds, const bf16* Q, const bf16* K, const bf16* Vt, bf16* O, const float* sinks, int bx, int G, int tid) {
    const int lane = tid & 63, r32 = lane & 31, hi = lane >> 5; const int wid = __builtin_amdgcn_readfirstlane(tid >> 6);
    constexpr int LKB = 0, LVB = 6 * KTILE;
    const int srow = tid >> 3, sch = tid & 7;
    for (int u = bx; u < 256; u += G) {
        const int b = u >> 6, kvh = (u >> 4) & 3, qb = u & 15, q0 = qb * 256;
        const size_t rowbase = (size_t)b * SEQ;
        const int tfirst = (qb == 0) ? 2 : 0;
        bf16x8 qn[4];
        { const bf16* qp = Q + (rowbase + q0 + wid * 32 + r32) * D + (kvh * 4) * HD + hi * 8;
#pragma unroll
          for (int d0 = 0; d0 < 4; ++d0) qn[d0] = *(const bf16x8*)(qp + d0 * 16); }
        __syncthreads();
        { const bf16* kg = K + (rowbase + q0 - 128 + srow) * 256 + kvh * HD + sch * 8;
          const bf16* vg = Vt + ((size_t)((b * NKV + kvh) * HD + srow)) * SEQ + (q0 - 128) + sch * 8;
          for (int t = 0; t < 6; ++t) { u32x4 kr = (u32x4){0u, 0u, 0u, 0u}, vr = kr;
              if (t >= tfirst) { kr = *(const u32x4*)(kg + (size_t)t * 64 * 256); vr = *(const u32x4*)(vg + t * 64); }
              *(LAS u32x4*)(lds + LKB + t * KTILE + srow * KSTR + sch * 16) = kr;
              *(LAS u32x2*)(lds + LVB + t * VTILE + srow * VSTR + sch * 16) = (u32x2){vr.x, vr.y}; *(LAS u32x2*)(lds + LVB + t * VTILE + srow * VSTR + sch * 16 + 8) = (u32x2){vr.z, vr.w}; } }
        __syncthreads();
#pragma unroll 1
        for (int task = wid; task < 32; task += 8) {
            const int g = task >> 3, w = task & 7, h = kvh * 4 + g;
            bf16x8 qr[4];
#pragma unroll
            for (int d0 = 0; d0 < 4; ++d0) qr[d0] = qn[d0];
            if (task + 8 < 32) { const bf16* qp = Q + (rowbase + q0 + w * 32 + r32) * D + (h + 1) * HD + hi * 8;
#pragma unroll
                for (int d0 = 0; d0 < 4; ++d0) qn[d0] = *(const bf16x8*)(qp + d0 * 16); }
            float mrun = sinks[h] * 1.4426950408889634f, lrun = (hi == 0) ? 1.f : 0.f; f32x16 o[2]; o[0] = f32x16{}; o[1] = f32x16{};
            const int t0 = (w >> 1) < 2 ? (w >> 1) : 2, kvrel_base = 64 * t0 - 128 - 32 * w, lowlim = (qb == 0) ? -(32 * w) : -2000000;
            { int ta = t0 + (w >= 6 ? 1 : 0), cnt = 3;
              if (ta < tfirst) { cnt -= tfirst - ta; ta = tfirst; }
              attn_task<MK_BAND, 0>(lds + LKB + ta * KTILE, lds + LVB + ta * VTILE, cnt, qr, mrun, lrun, o, kvrel_base + 64 * (ta - t0), lowlim, r32, hi); }
            const float lt = lrun + __shfl_xor(lrun, 32);
            store_o(O + (rowbase + q0 + w * 32 + r32) * D + h * HD, o, 1.0f / lt, hi, true);
        }
    }
}
}

namespace att {
constexpr int LIST_CAP = 3840, CHUNK = 4096;
__device__ __forceinline__ void moba_gate_phase(LAS unsigned char* lds, const bf16* Q, const float* kmp, unsigned* counts, unsigned* lists, int bx, int G, int tid) {
    const int lane = tid & 63, hw = tid >> 8, t256 = tid & 255;
    LAS float* km = (LAS float*)lds + hw * 1024;
    for (int up = bx; up < 32 * 15; up += G) {
        const int u = 2 * up + hw;
        const int bh = u / 15, i = 1 + (u - bh * 15), b = bh >> 4, h = bh & 15;
        __syncthreads();
        for (int t = t256; t < i * 64; t += 256) { const int j = t >> 6, d = t & 63; const float* p = kmp + (size_t)((b * 16 + j) * 2) * 1024 + h * HD + d; km[t] = (p[0] + p[1024]) * (1.0f / 256.0f); }
        __syncthreads();
        {
            const int s = i * 256 + t256;
            const bf16* qp = Q + ((size_t)b * SEQ + s) * D + h * HD;
            float g[16];
#pragma unroll
            for (int j = 0; j < 16; ++j) g[j] = 0.f;
#pragma unroll
            for (int dc = 0; dc < 8; ++dc) {
                const bf16x8 qv = *(const bf16x8*)(qp + dc * 8); float qf[8];
#pragma unroll
                for (int e = 0; e < 8; ++e) qf[e] = bf2f((unsigned short)qv[e]);
#pragma unroll
                for (int j = 0; j < 15; ++j) if (j < i) { const LAS f32x4* kp = (const LAS f32x4*)(km + j * 64 + dc * 8); const f32x4 k0 = kp[0], k1 = kp[1];
                    g[j] += (qf[0] * k0[0] + qf[1] * k0[1]) + (qf[2] * k0[2] + qf[3] * k0[3]) + (qf[4] * k1[0] + qf[5] * k1[1]) + (qf[6] * k1[2] + qf[7] * k1[3]); }
            }
            unsigned sel = 0u; int sj0 = -1, sj1 = -1;
            const int nsel = i < 3 ? i : 3;
#pragma unroll
            for (int t = 0; t < 3; ++t) if (t < nsel) {
                float best = -3.0e38f; int bi = 0;
#pragma unroll
                for (int j = 0; j < 15; ++j) { const bool ok = (j < i) && !((sel >> j) & 1u) && (g[j] > best); best = ok ? g[j] : best; bi = ok ? j : bi; }
                sel |= 1u << bi; if (t == 0) sj0 = bi; if (t == 1) sj1 = bi;
            }
            unsigned mycnt = 0u, rk0 = 0u, rk1 = 0u, rk2 = 0u; int sj2 = -1;
            for (int j = 0; j < i; ++j) {
                const bool has = (sel >> j) & 1u;
                const unsigned long long mask = __ballot(has);
                const unsigned below = (unsigned)__popcll(mask & ((1ull << lane) - 1ull));
                if (lane == j) mycnt = (unsigned)__popcll(mask);
                if (has) { if (j == sj0) rk0 = below; else if (j == sj1) rk1 = below; else { rk2 = below; sj2 = j; } }
            }
            unsigned base = 0u;
            if (lane < i && mycnt != 0u) base = atomicAdd(&counts[lane * 64 + bh], mycnt);
            const unsigned b0 = (unsigned)__shfl((int)base, sj0 < 0 ? 0 : sj0), b1 = (unsigned)__shfl((int)base, sj1 < 0 ? 0 : sj1), b2 = (unsigned)__shfl((int)base, sj2 < 0 ? 0 : sj2);
            if (sj0 >= 0) lists[(size_t)(sj0 * 64 + bh) * LIST_CAP + b0 + rk0] = (unsigned)s | (1u << 12);
            if (sj1 >= 0) lists[(size_t)(sj1 * 64 + bh) * LIST_CAP + b1 + rk1] = (unsigned)s | (2u << 12);
            if (sj2 >= 0) lists[(size_t)(sj2 * 64 + bh) * LIST_CAP + b2 + rk2] = (unsigned)s | (3u << 12);
        }
    }
}
__device__ __forceinline__ void moba_sparse_phase(LAS unsigned char* lds, const bf16* Q, const bf16* K, const bf16* Vt, bf16* PO0, bf16* PO3, float* PL, const unsigned* counts, const unsigned* lists, int bx, int G, int tid) {
    const int lane = tid & 63, r32 = lane & 31, hi = lane >> 5; const int wid = __builtin_amdgcn_readfirstlane(tid >> 6);
    constexpr int BUFB = 4 * KTILE + 4 * VTILE, LPFX = 2 * BUFB, LCNT = LPFX + 1032 * 4, LWT = LCNT + 1024 * 4;
    LAS unsigned* pfx = (LAS unsigned*)(lds + LPFX); LAS unsigned* cnt = (LAS unsigned*)(lds + LCNT); LAS unsigned* wtot = (LAS unsigned*)(lds + LWT);
    __syncthreads();
    { const unsigned n0 = counts[2 * tid], n1 = counts[2 * tid + 1]; cnt[2 * tid] = n0; cnt[2 * tid + 1] = n1;
      const unsigned c0 = (((n0 + 31u) & ~31u) + 256u + CHUNK - 1) / CHUNK, c1 = (((n1 + 31u) & ~31u) + 256u + CHUNK - 1) / CHUNK; unsigned inc = c0 + c1;
#pragma unroll
      for (int o = 1; o < 64; o <<= 1) { const unsigned t = (unsigned)__shfl_up((int)inc, o); if (lane >= o) inc += t; }
      if (lane == 63) wtot[wid] = inc;
      __syncthreads();
      unsigned off = 0u;
#pragma unroll
      for (int w = 0; w < 8; ++w) if (w < wid) off += wtot[w];
      inc += off; pfx[2 * tid] = inc - c0 - c1; pfx[2 * tid + 1] = inc - c1; if (tid == 511) pfx[1024] = inc;
      __syncthreads(); }
    const int NTOT = (int)__builtin_amdgcn_readfirstlane((int)pfx[1024]);
    const int srow = tid >> 3, sch = tid & 7;
#define DECODE(k_, li_, c_) do { const unsigned e_ = (unsigned)__builtin_amdgcn_readfirstlane((int)utab[(k_)]); li_ = (int)(e_ & 0xffffu); c_ = (int)(e_ >> 16); } while (0)
#define KV_ISSUE(bh_, j_) do { const bf16* kg_ = K + ((size_t)((bh_) >> 4) * SEQ + (j_) * 256 + srow) * D + ((bh_) & 15) * HD + sch * 8; \
        const bf16* vg_ = Vt + ((size_t)((bh_) * HD + srow)) * SEQ + (j_) * 256 + sch * 8; \
        _Pragma("unroll") for (int t = 0; t < 4; ++t) { kreg[t] = *(const u32x4*)(kg_ + (size_t)t * 64 * D); vreg[t] = *(const u32x4*)(vg_ + t * 64); } } while (0)
#define KV_COMMIT(buf_) do { _Pragma("unroll") for (int t = 0; t < 4; ++t) { LAS unsigned char* kb_ = lds + (buf_) * BUFB + t * KTILE + srow * KSTR + sch * 16; LAS unsigned char* vb_ = lds + (buf_) * BUFB + 4 * KTILE + t * VTILE + srow * VSTR + sch * 16; \
        *(LAS u32x4*)kb_ = kreg[t]; *(LAS u32x2*)vb_ = (u32x2){vreg[t].x, vreg[t].y}; *(LAS u32x2*)(vb_ + 8) = (u32x2){vreg[t].z, vreg[t].w}; } } while (0)
    const unsigned jt_ = ((bx >> 6) == 0) ? 0xec70u : ((bx >> 6) == 1) ? 0xf961u : ((bx >> 6) == 2) ? 0xdb42u : 0xa853u;
    const bool fixed_deal = (G == 256) && (NTOT == 1024);
#define UNIT_OF(k_) (fixed_deal ? (((k_) < 4) ? (int)((jt_ >> (4 * (k_))) & 15u) * 64 + (bx & 63) : NTOT) : ((k_) * G + (((k_) & 1) ? G - 1 - bx : bx)))
    { LAS unsigned* utab_w = (LAS unsigned*)(lds + LWT + 64);
#pragma unroll
      for (int q = 0; q < 2; ++q) { const int li_ = 2 * tid + q; const int lo_ = (int)pfx[li_], hi_ = (int)pfx[li_ + 1];
          for (int k_ = 0; k_ * G < NTOT && k_ < 64; ++k_) { const int u_ = UNIT_OF(k_); if (u_ >= lo_ && u_ < hi_) utab_w[k_] = (unsigned)li_ | ((unsigned)(u_ - lo_) << 16); } }
      __syncthreads(); }
    const LAS unsigned* utab = (const LAS unsigned*)(lds + LWT + 64);
    int u = UNIT_OF(0); if (u >= NTOT) return;
    int li, c; DECODE(0, li, c);
    { u32x4 kreg[4], vreg[4]; KV_ISSUE(li & 63, li >> 6); KV_COMMIT(0); }
    int bh, j, h, n, n32, ntasks, i0; size_t rowbase; unsigned e_cur, e_nxt; bf16x8 qn[4];
#define ENTRY(task_) (((task_) >= ntasks) ? 0u : ((i0 + (task_) * 32 >= n32) ? (unsigned)(j * 256 + (i0 + (task_) * 32 - n32) + r32) \
                                              : lists[(size_t)li * LIST_CAP + ((i0 + (task_) * 32 + r32) < n ? (i0 + (task_) * 32 + r32) : n - 1)]))
#define UNIT_SETUP() do { bh = li & 63; j = li >> 6; h = bh & 15; rowbase = (size_t)(bh >> 4) * SEQ; \
        n = (int)__builtin_amdgcn_readfirstlane((int)cnt[li]); n32 = (n + 31) & ~31; \
        { const int len_ = n32 + 256, nch_ = (len_ + CHUNK - 1) / CHUNK, csz_ = (((len_ >> 5) + nch_ - 1) / nch_) << 5;       \
          int nhere_ = len_ - c * csz_; nhere_ = nhere_ > csz_ ? csz_ : nhere_; ntasks = nhere_ >> 5; i0 = c * csz_; } \
        e_cur = ENTRY(wid); e_nxt = ENTRY(wid + 8); \
        if (wid < ntasks) { const bf16* qp_ = Q + (rowbase + (e_cur & 4095u)) * D + h * HD + hi * 8; \
            _Pragma("unroll") for (int d0 = 0; d0 < 4; ++d0) qn[d0] = *(const bf16x8*)(qp_ + d0 * 16); } } while (0)
    UNIT_SETUP();
    __syncthreads();
    for (int k = 0; u < NTOT; ++k, u = UNIT_OF(k)) {
        const int un = UNIT_OF(k + 1); const bool has_next = un < NTOT;
        int li2 = 0, c2 = 0; if (has_next) DECODE(k + 1, li2, c2);
        const LAS unsigned char* Kb = lds + (k & 1) * BUFB; const LAS unsigned char* Vb = Kb + 4 * KTILE;
#pragma unroll 1
        for (int task = wid; task < ntasks; task += 8) {
            bf16x8 qr[4];
#pragma unroll
            for (int d0 = 0; d0 < 4; ++d0) qr[d0] = qn[d0];
            const unsigned e_me = e_cur; e_cur = e_nxt; e_nxt = ENTRY(task + 16);
            const int s = (int)(e_me & 4095u), slot = (int)(e_me >> 12);
            const int ti = i0 + task * 32;
            const bool ownt = ti >= n32, valid = ownt || (ti + r32) < n;
            if (task + 8 < ntasks) { const bf16* qp = Q + (rowbase + (e_cur & 4095u)) * D + h * HD + hi * 8;
#pragma unroll
                for (int d0 = 0; d0 < 4; ++d0) qn[d0] = *(const bf16x8*)(qp + d0 * 16); }
            float mrun = MINIT, lrun = 0.f; f32x16 o[2]; o[0] = f32x16{}; o[1] = f32x16{};
#pragma unroll 1
            for (int trep = 0; trep < PROBE_TASKREP; ++trep) {
                mrun = MINIT; lrun = 0.f; o[0] = f32x16{}; o[1] = f32x16{};
                if (ownt) { const int ow = (ti - n32) >> 5; attn_task<MK_CAUSAL, 0>(Kb, Vb, ((ow * 32 + 31) >> 6) + 1, qr, mrun, lrun, o, -32 * ow, 0, r32, hi); }
                else attn_task<MK_NONE, 4>(Kb, Vb, 4, qr, mrun, lrun, o, 0, 0, r32, hi);
            }
            const float lt = lrun + __shfl_xor(lrun, 32);
#pragma unroll 1
            for (int srep = 0; srep < PROBE_STOREREP; ++srep) {
                store_o(((slot < 3) ? PO0 + (size_t)slot * M * D : PO3) + (rowbase + s) * D + h * HD, o, 1.0f / lt, hi, valid);
                if (valid && hi == 0) PL[((size_t)slot * M + rowbase + s) * 16 + h] = mrun + __builtin_amdgcn_logf(lt);
                asm volatile("" ::: "memory");
            }
        }
        li = li2; c = c2;
#pragma unroll 1
        for (int urep = 0; urep < PROBE_UNITREP; ++urep)
        { if (urep + 1 < PROBE_UNITREP) { int l3 = 0, c3 = 0; if (has_next) DECODE(k + 1, l3, c3); asm volatile("" :: "s"(l3), "s"(c3)); __syncthreads(); }
        if (has_next) {
            u32x4 kreg[4], vreg[4]; KV_ISSUE(li & 63, li >> 6); UNIT_SETUP(); KV_COMMIT((k + 1) & 1); }
        }
        __syncthreads();
    }
#undef ENTRY
#undef UNIT_SETUP
#undef UNIT_OF
#undef DECODE
#undef KV_ISSUE
#undef KV_COMMIT
}
__device__ __forceinline__ void moba_combine_phase(bf16* O, const bf16* PO0, const bf16* PO3, const float* PL, int gtid, int nthreads) {
    for (int idx = gtid; idx < M * 128; idx += nthreads) {
        const int row = idx >> 7, rem = idx & 127, h = rem >> 3, dc = rem & 7;
        const int qblk = (row & (SEQ - 1)) >> 8, nv = 1 + (qblk < 3 ? qblk : 3);
        float lse[4], mx = -3.0e38f;
#pragma unroll
        for (int s = 0; s < 4; ++s) { lse[s] = (s < nv) ? PL[((size_t)s * M + row) * 16 + h] : -3.0e38f; mx = fmaxf(mx, lse[s]); }
        float acc[8], wsum = 0.f;
#pragma unroll
        for (int e = 0; e < 8; ++e) acc[e] = 0.f;
#pragma unroll
        for (int s = 0; s < 4; ++s) if (s < nv) {
            const float w = __builtin_amdgcn_exp2f(lse[s] - mx); wsum += w;
            const bf16x8 v = *(const bf16x8*)(((s < 3) ? PO0 + (size_t)s * M * D : PO3) + (size_t)row * D + h * HD + dc * 8);
#pragma unroll
            for (int e = 0; e < 8; ++e) acc[e] += w * bf2f((unsigned short)v[e]);
        }
        const float inv = 1.0f / wsum;
        u32x4 w; w.x = cvt_pk_bf16(acc[0] * inv, acc[1] * inv); w.y = cvt_pk_bf16(acc[2] * inv, acc[3] * inv); w.z = cvt_pk_bf16(acc[4] * inv, acc[5] * inv); w.w = cvt_pk_bf16(acc[6] * inv, acc[7] * inv);
        *(u32x4*)(O + (size_t)row * D + h * HD + dc * 8) = w;
    }
}
}

__device__ __forceinline__ void conv_fix_phase(bf16* ACT, const bf16* head, const bf16* tail, const float* cw, const float* cb, int gtid, int nthreads) {
    constexpr int NCG = DFF / 8, NST = M / 64;
    for (int it = gtid; it < NCG * NST * 2; it += nthreads) {
        const int rk = it / NCG, cgi = it - rk * NCG, c = cgi * 8, k = rk & 1, st = rk >> 1;
        const bool bstart = (st & 63) == 0;
        const bf16* p0 = head + (size_t)(st * 2 + k) * DFF2 + c;
        const bf16* p1 = (k == 1) ? head + (size_t)(st * 2) * DFF2 + c : tail + (size_t)((st - 1) * 2 + 1) * DFF2 + c;
        const bf16* p2 = tail + (size_t)((st - 1) * 2 + k) * DFF2 + c;
        const bool z1 = bstart && (k == 0), z2 = bstart;
        const bf16x8 zero = (bf16x8){0, 0, 0, 0, 0, 0, 0, 0};
        const bf16x8 g0 = *(const bf16x8*)p0, v0 = *(const bf16x8*)(p0 + DFF);
        const bf16x8 g1 = z1 ? zero : *(const bf16x8*)p1, v1 = z1 ? zero : *(const bf16x8*)(p1 + DFF);
        const bf16x8 g2 = z2 ? zero : *(const bf16x8*)p2, v2 = z2 ? zero : *(const bf16x8*)(p2 + DFF);
        float r[8];
#pragma unroll
        for (int h2 = 0; h2 < 2; ++h2) {
            const int cc = c + 4 * h2;
            const f32x4 wg0 = *(const f32x4*)(cw + cc), wg1 = *(const f32x4*)(cw + DFF2 + cc), wg2 = *(const f32x4*)(cw + 2 * DFF2 + cc), bgv = *(const f32x4*)(cb + cc);
            const f32x4 wv0 = *(const f32x4*)(cw + DFF + cc), wv1 = *(const f32x4*)(cw + DFF2 + DFF + cc), wv2 = *(const f32x4*)(cw + 2 * DFF2 + DFF + cc), bvv = *(const f32x4*)(cb + DFF + cc);
#pragma unroll
            for (int j = 0; j < 4; ++j) { const int e = 4 * h2 + j;
                const float gc = bgv[j] + wg0[j] * bf2f((unsigned short)g2[e]) + wg1[j] * bf2f((unsigned short)g1[e]) + wg2[j] * bf2f((unsigned short)g0[e]);
                const float vc = bvv[j] + wv0[j] * bf2f((unsigned short)v2[e]) + wv1[j] * bf2f((unsigned short)v1[e]) + wv2[j] * bf2f((unsigned short)v0[e]);
                r[e] = gc * __builtin_amdgcn_rcpf(1.0f + __builtin_amdgcn_exp2f(-gc * 1.4426950408889634f)) * vc; }
        }
        u32x4 w; w.x = cvt_pk_bf16(r[0], r[1]); w.y = cvt_pk_bf16(r[2], r[3]); w.z = cvt_pk_bf16(r[4], r[5]); w.w = cvt_pk_bf16(r[6], r[7]);
        *(u32x4*)(ACT + (size_t)(st * 64 + k) * DFF + c) = w;
    }
}

#define GAS __attribute__((address_space(1)))
#define XB_TMO      128
#define XB_XCNT(j)  (256  + 64 * (j))
#define XB_XSUB(j)  (1280 + 64 * (j))
#define XB_XGEN(j)  (2304 + 64 * (j))
#define XB_TOP      3328
#define XB_TOPGEN   3392
#define XCD_BAR_WORDS 3456
#define XB_SPIN_CAP (1u << 18)

__device__ __forceinline__ unsigned xb_ld(unsigned* p)              { return __hip_atomic_load(p, __ATOMIC_RELAXED, __HIP_MEMORY_SCOPE_AGENT); }
__device__ __forceinline__ unsigned xb_add(unsigned* p, unsigned v) { return __hip_atomic_fetch_add(p, v, __ATOMIC_RELAXED, __HIP_MEMORY_SCOPE_AGENT); }
__device__ __forceinline__ unsigned xb_xcc_id() { return (unsigned)__builtin_amdgcn_s_getreg((3 << 11) | 20) & 0xFu; }
#define XB_SPIN(cond, bar) do { unsigned _sp = 0; while (cond) { __builtin_amdgcn_s_sleep(1); \
    if ((++_sp & 255u) == 0u) { if (xb_ld(&(bar)[XB_TMO])) break; if (_sp > XB_SPIN_CAP) { atomicAdd(&(bar)[XB_TMO], 1u); break; } } } } while (0)

struct XcdBarrier {
    unsigned* bar; unsigned x;
    volatile LAS unsigned* st;
};

__device__ __forceinline__ XcdBarrier xcd_barrier_post(unsigned* bar, volatile LAS unsigned* st, const int tid_) {
    XcdBarrier b; b.bar = bar; b.x = xb_xcc_id(); b.st = st;
    if (tid_ == 0) (void)xb_add(&bar[XB_XCNT(b.x)], 1u);
    return b;
}
__device__ __forceinline__ void xcd_barrier_complete(unsigned* bar, unsigned x, unsigned& nloc, unsigned& nx) {
    const unsigned G = gridDim.x * gridDim.y * gridDim.z;
    unsigned sum, cnt, mine, sp = 0u;
    for (;;) {
        sum = 0u; cnt = 0u; mine = 0u;
#pragma unroll
        for (unsigned j = 0; j < 16; ++j) { const unsigned c = xb_ld(&bar[XB_XCNT(j)]); sum += c; cnt += (c > 0u) ? 1u : 0u; mine = (j == x) ? c : mine; }
        if (sum == G) break;
        __builtin_amdgcn_s_sleep(1);
        if ((++sp & 255u) == 0u) { if (xb_ld(&bar[XB_TMO])) break; if (sp > XB_SPIN_CAP) { atomicAdd(&bar[XB_TMO], 1u); break; } }
    }
    nloc = mine > 0u ? mine : 1u; nx = cnt > 0u ? cnt : 1u;
}

__device__ __forceinline__ void xcd_barrier(const XcdBarrier& b, const int tid_) {
    asm volatile("s_waitcnt vmcnt(0)" ::: "memory");
    __syncthreads();
    if (tid_ == 0) {
        unsigned* bar = b.bar;
        __builtin_amdgcn_s_waitcnt(0);
        unsigned nloc = b.st[0], nx = b.st[1];
        if (nloc == 0u) { xcd_barrier_complete(bar, b.x, nloc, nx); b.st[0] = nloc; b.st[1] = nx; }
        const unsigned old = xb_add(&bar[XB_XSUB(b.x)], 1u);
        const unsigned gen = old / nloc;
        if (old + 1u == (gen + 1u) * nloc) {
            __builtin_amdgcn_fence(__ATOMIC_RELEASE, "agent");
            asm volatile("s_waitcnt vmcnt(0)" ::: "memory");
            const unsigned og = xb_add(&bar[XB_TOP], 1u);
            const unsigned tg = og / nx;
            if (og + 1u == (tg + 1u) * nx) xb_add(&bar[XB_TOPGEN], 1u);
            else XB_SPIN(xb_ld(&bar[XB_TOPGEN]) == tg, bar);
            __builtin_amdgcn_fence(__ATOMIC_ACQUIRE, "agent");
            xb_add(&bar[XB_XGEN(b.x)], 1u);
            asm volatile("s_waitcnt vmcnt(0)" ::: "memory");
        } else {
            XB_SPIN(xb_ld(&bar[XB_XGEN(b.x)]) == gen, bar);
            __builtin_amdgcn_fence(__ATOMIC_ACQUIRE, "agent");
            asm volatile("s_waitcnt vmcnt(0)" ::: "memory");
        }
    }
    __syncthreads();
}

__device__ __forceinline__ int mk_wave(int w) { asm volatile("" : "+s"(w)); return w; }
__device__ __forceinline__ int mk_lane() { int l; asm volatile("v_mbcnt_lo_u32_b32 %0, -1, 0\n\tv_mbcnt_hi_u32_b32 %0, -1, %0" : "=v"(l)); return l; }
#define PROBE_DUP_KINDS 0
#define PROBE_DUP_LAYERS 15
#define PROBE_XSYNC 0
#define PROBE_REPS(ph) (((((ph) >= 1 && (ph) <= 32) && ((PROBE_DUP_KINDS >> (((ph) - 1) % 8)) & 1)) || ((ph) == 0 && (PROBE_DUP_KINDS & 256))) && ((PROBE_DUP_LAYERS >> (((ph) - 1) / 8)) & 1) ? 2 : 1)
__global__ void __launch_bounds__(NWAVES * 64) yoco_fwd(Args a_kernarg) {
    extern __shared__ __attribute__((aligned(16))) unsigned char lds_raw[];
    cg::grid_group grid = cg::this_grid();
    LAS unsigned char* lds = (LAS unsigned char*)lds_raw;
    const int G0 = gridDim.x, bx0 = blockIdx.x;
    volatile LAS unsigned* MISC = (volatile LAS unsigned*)(lds + LDS_BYTES - 512);
    unsigned* barw = (unsigned*)a_kernarg.ws;
    const int wave_s = __builtin_amdgcn_readfirstlane((int)threadIdx.x >> 6);
#define MK_TID() ((mk_wave(wave_s) << 6) | mk_lane())
    { const int t0 = MK_TID(); if (t0 < 64) MISC[t0] = 0u;
    }
    __syncthreads();
    (void)xcd_barrier_post(barw, MISC + 8, MK_TID());
    const int lo = a_kernarg.ph_lo, hi = a_kernarg.ph_hi;
    for (int ph = lo; ph < hi; ++ph) {
    for (int rep = 0; rep < PROBE_REPS(ph); ++rep) {
    int G = G0, bx = bx0; asm volatile("" : "+s"(G), "+s"(bx));
    const int vcu = (G % 8 == 0) ? (bx % 8) * (G / 8) + bx / 8 : bx;
    ArgsP ap = (ArgsP)__builtin_amdgcn_kernarg_segment_ptr(); asm volatile("" : "+s"(ap));
    unsigned char* ws = a.ws;
    float* ssq = (float*)(ws + WS_SSQ); const float* cs = (const float*)(ws + WS_CS); float* kmp = (float*)(ws + WS_KMP);
    bf16* xb = (bf16*)(ws + WS_XB); bf16* QO = (bf16*)(ws + WS_QO); bf16* Kb = (bf16*)(ws + WS_K); bf16* VT = (bf16*)(ws + WS_VT);
    bf16* KS = (bf16*)(ws + WS_KS); bf16* VTS = (bf16*)(ws + WS_VTS); bf16* U = (bf16*)(ws + WS_U); bf16* HALO = (bf16*)(ws + WS_HALO); bf16* OB = (bf16*)(ws + WS_O);
    {
        if (ph == 0) {
            prologue(ap, lds, vcu * NWAVES + mk_wave(wave_s), G * NWAVES, mk_lane());
        } else if (ph == 33) {
            const int gw = vcu * NWAVES + mk_wave(wave_s), NGW = G * NWAVES; const int lane = mk_lane();
            f32x4 gv[4];
#pragma unroll
            for (int j = 0; j < 4; ++j) gv[j] = *((const f32x4*)a.final_norm + lane + 64 * j);
#define FIN_RSTD(m_) ({ const f32x4* sp_ = (const f32x4*)(ssq + (size_t)(m_) * 16); const f32x4 s0 = sp_[0], s1 = sp_[1], s2 = sp_[2], s3 = sp_[3]; \
                1.0f / sqrtf((((s0[0] + s0[1]) + (s0[2] + s0[3])) + ((s1[0] + s1[1]) + (s1[2] + s1[3])) + ((s2[0] + s2[1]) + (s2[2] + s2[3])) + ((s3[0] + s3[1]) + (s3[2] + s3[3]))) * (1.0f / D) + 1e-6f); })
#define FIN_ROW(m_, H_, R_) do { f32x4* xr_ = (f32x4*)(a.out + (size_t)(m_) * D) + lane; \
                _Pragma("unroll") for (int j = 0; j < 4; ++j) { const unsigned long long h_ = H_[j]; f32x4 v_; \
                    v_[0] = bf2f((unsigned short)(h_ & 0xffffu)); v_[1] = bf2f((unsigned short)((h_ >> 16) & 0xffffu)); v_[2] = bf2f((unsigned short)((h_ >> 32) & 0xffffu)); v_[3] = bf2f((unsigned short)(h_ >> 48)); \
                    xr_[64 * j] = v_ * (R_) * gv[j]; } } while (0)
#define FIN_LOAD(m_, H_) do { const unsigned long long* hr_ = (const unsigned long long*)((const bf16*)(ws + WS_XH2) + (size_t)(m_) * D) + lane; \
                _Pragma("unroll") for (int j = 0; j < 4; ++j) H_[j] = hr_[64 * j]; } while (0)
            int m0 = gw;
            for (; m0 + NGW < M; m0 += 2 * NGW) {
                unsigned long long ha[4], hb[4];
                FIN_LOAD(m0, ha); FIN_LOAD(m0 + NGW, hb);
                const float ra = FIN_RSTD(m0), rb = FIN_RSTD(m0 + NGW);
                FIN_ROW(m0, ha, ra); FIN_ROW(m0 + NGW, hb, rb);
            }
            for (; m0 < M; m0 += NGW) { unsigned long long ha[4]; FIN_LOAD(m0, ha); const float ra = FIN_RSTD(m0); FIN_ROW(m0, ha, ra); }
#undef FIN_RSTD
#undef FIN_ROW
#undef FIN_LOAD
        } else {
            const int l = (ph - 1) / 8, kind = (ph - 1) % 8;
            if (l >= 2 && (kind == 1 || kind == 3)) continue;
            unsigned* counts = (unsigned*)(ws + WS_COUNTS); unsigned* lists = (unsigned*)(ws + WS_LISTS);
            bf16* PO0 = (bf16*)(ws + WS_PO0); bf16* PO3 = (bf16*)a.out + (size_t)M * D; float* PL = (float*)(ws + WS_PL);
            if (kind == 0) {
                if (l < 2 && bx == 0) { unsigned z = 0u; asm volatile("" : "+v"(z)); counts[2 * MK_TID()] = z; counts[2 * MK_TID() + 1] = z; counts[1024 + 2 * MK_TID()] = z; counts[1025 + 2 * MK_TID()] = z; }
                pg8::Gemm g; pg8::EpiQKV E;
                E.ssq = ssq; E.cs = cs; E.qscale = C2; E.Q = QO;
                if (l < 2) { g = pg8::Gemm{xb, (const bf16*)(ws + WS_WQKV) + (size_t)l * 3 * D * D, M, 3 * D, D, D}; E.Kd = Kb; E.Vt = VT; E.kmp = kmp; E.nQ = 4; E.nK = 4; E.kpitch = 1024; }
                else if (l == 2) { g = pg8::Gemm{xb, (const bf16*)(ws + WS_WQ2), M, 1536, D, D}; E.Kd = KS; E.Vt = VTS; E.kmp = nullptr; E.nQ = 4; E.nK = 1; E.kpitch = 256; }
                else { g = pg8::Gemm{xb, (const bf16*)(ws + WS_WQ3), M, D, D, D}; E.Kd = KS; E.Vt = VTS; E.kmp = nullptr; E.nQ = 4; E.nK = 1; E.kpitch = 256; }
                pg8::StaticOrder S; S.init(M, g.N, G, bx);
                pg8::gemm_phase<pg8::EpiQKV, pg8::StaticOrder, true, true>(lds, g, S, E, MK_TID());
            } else if (kind == 1) {
                att::moba_gate_phase(lds, QO, kmp, rep ? counts + 1024 : counts, rep ? (unsigned*)PO0 : lists, bx, G, MK_TID());
            } else if (kind == 2) {
                if (l < 2) att::moba_sparse_phase(lds, QO, Kb, VT, PO0, PO3, PL, counts, lists, bx, G, MK_TID());
                else att::swa_phase(lds, QO, KS, VTS, OB, a.sinks_b + (l - 2) * H, bx, G, MK_TID());
            } else if (kind == 3) {
                att::moba_combine_phase(QO, PO0, PO3, PL, bx * 512 + MK_TID(), G * 512);
            } else if (kind == 4 || kind == 7) {
                pg8::Gemm g; pg8::EpiResid E;
                if (kind == 4) g = pg8::Gemm{(l < 2) ? QO : OB, (const bf16*)(ws + WS_WO) + (size_t)l * D * D, M, D, D, D};
                else g = pg8::Gemm{U, (const bf16*)(ws + WS_WDN) + (size_t)l * D * DFF, M, D, DFF, DFF};
                const bool lastg = (l == 3 && kind == 7);
                E.hin = xb; E.lin = (const bf16*)a.out; E.hout = lastg ? (bf16*)(ws + WS_XH2) : xb; E.lout = lastg ? (bf16*)(ws + WS_XL2) : (bf16*)a.out; E.ssq = ssq;
                pg8::StaticOrder S; S.init(M, D, G, bx);
                pg8::gemm_phase<pg8::EpiResid, pg8::StaticOrder, true, true>(lds, g, S, E, MK_TID());
            } else if (kind == 5) {
                pg8::Gemm g{xb, (const bf16*)(ws + WS_WUP) + (size_t)l * DFF2 * D, M, DFF2, D, D};
                pg8::EpiUpConv E{U, HALO, HALO + (size_t)(M / 64) * 2 * DFF2, ssq, a.conv_w + (size_t)l * 3 * DFF2, a.conv_b + (size_t)l * DFF2};
                pg8::StaticOrder S; S.init(M, DFF2, G, bx);
                pg8::gemm_phase<pg8::EpiUpConv, pg8::StaticOrder, true, true>(lds, g, S, E, MK_TID());
                if (l < 3) {
                    const int nun = (M / 256) * (DFF2 / 256), rem = nun % G;
                    const bool idle = (rem != 0) && (bx >= rem);
                    if (idle || rem == 0) { const int widx = (rem != 0) ? bx - rem : bx, nwk = (rem != 0) ? G - rem : G;
                        convert_layer(ap, lds, l + 1, widx * NWAVES + mk_wave(wave_s), nwk * NWAVES, mk_wave(wave_s), mk_lane()); }
                }
            } else {
                conv_fix_phase(U, HALO, HALO + (size_t)(M / 64) * 2 * DFF2, a.conv_w + (size_t)l * 3 * DFF2, a.conv_b + (size_t)l * DFF2, bx * 512 + MK_TID(), G * 512);
            }
        }
        if (ph + 1 < hi || rep + 1 < PROBE_REPS(ph)) { if (lo < 0) grid.sync();        XcdBarrier bar; bar.bar = (unsigned*)ws; bar.x = xb_xcc_id(); bar.st = MISC + 8; xcd_barrier(bar, MK_TID()); }
    }
    }
    }
}
#undef a

extern "C" void kernel_launch(void* const* d_in, const int* in_sizes, int n_in, void* d_out, int out_size, void* d_ws, size_t ws_size, hipStream_t stream) {
    static int grid = 0;
    if (grid == 0) {
        if (n_in != 16 || out_size != M * D || ws_size < WS_END) { fprintf(stderr, "kernel_launch: unexpected shapes n_in %d out %d ws %zu\n", n_in, out_size, ws_size); grid = -1; return; }
        int dev = 0, cus = 0, per_cu = 0;
        hipGetDevice(&dev); hipDeviceGetAttribute(&cus, hipDeviceAttributeMultiprocessorCount, dev);
        if (hipFuncSetAttribute((const void*)yoco_fwd, hipFuncAttributeMaxDynamicSharedMemorySize, LDS_BYTES) != hipSuccess) { fprintf(stderr, "kernel_launch: hipFuncSetAttribute failed\n"); grid = -1; return; }
        if (hipOccupancyMaxActiveBlocksPerMultiprocessor(&per_cu, (const void*)yoco_fwd, NWAVES * 64, LDS_BYTES) != hipSuccess || per_cu < 1) { fprintf(stderr, "kernel_launch: occupancy query failed (%d)\n", per_cu); per_cu = 1; (void)hipGetLastError(); }
        grid = cus * per_cu;
    }
    if (grid < 0) return;
    Args a{};
    a.x = (const float*)d_in[0]; a.pos = (const int*)d_in[1]; a.attn_norm = (const float*)d_in[2]; a.w_qkv_a = (const float*)d_in[3]; a.w_o_a = (const float*)d_in[4];
    a.kv_norm = (const float*)d_in[5]; a.w_kv_b = (const float*)d_in[6]; a.w_q_b = (const float*)d_in[7]; a.sinks_b = (const float*)d_in[8]; a.w_o_b = (const float*)d_in[9];
    a.ffn_norm = (const float*)d_in[10]; a.w_up = (const float*)d_in[11]; a.conv_w = (const float*)d_in[12]; a.conv_b = (const float*)d_in[13]; a.w_down = (const float*)d_in[14];
    a.final_norm = (const float*)d_in[15]; a.out = (float*)d_out; a.ws = (unsigned char*)d_ws;
    a.ph_lo = 0; a.ph_hi = 34;
    if (hipMemsetAsync(d_ws, 0, 16384, stream) != hipSuccess) { fprintf(stderr, "kernel_launch: hipMemsetAsync of the barrier words failed\n"); return; }
    void* args[] = {&a};
    hipError_t e = hipLaunchCooperativeKernel((const void*)yoco_fwd, dim3(grid), dim3(NWAVES * 64), args, LDS_BYTES, stream);
    if (e != hipSuccess) fprintf(stderr, "cooperative launch failed: %s (grid %d)\n", hipGetErrorString(e), grid);
}
```
